# Optimizing an MI355X kernel written in HIP

```python
import math
import jax, jax.numpy as jnp
from jax import lax
import numpy as np

D_MODEL = 1024
BATCH = 4
SEQ = 8192
DEPTH = 2

HEAD_DIM = 64
ROT_DIM = HEAD_DIM // 4
ROPE_THETA = 500000.0
NORM_EPS = 1e-6
D_FF = 2816

MOBA_HEADS = 8
MOBA_BLOCK = 256
MOBA_TOPK = 3
MOBA_Q_CHUNK = 64
MOBA_WIDTH = MOBA_HEADS * HEAD_DIM
GMLP_GROUPS = 8
GMLP_GROUP_DIM = 64
GMLP_CHUNK = 128
GMLP_WIDTH = GMLP_GROUPS * GMLP_GROUP_DIM
EVEN_IN = 3 * MOBA_WIDTH + 2 * GMLP_WIDTH
EVEN_OUT = MOBA_WIDTH + GMLP_WIDTH

DIFF_HEADS = 8
DIFF_QK_DIM = HEAD_DIM
DIFF_V_DIM = 2 * HEAD_DIM
DIFF_QK_WIDTH = DIFF_HEADS * 2 * DIFF_QK_DIM
DIFF_WIDTH = DIFF_HEADS * DIFF_V_DIM
ODD_IN = 2 * DIFF_QK_WIDTH + DIFF_WIDTH
DIFF_Q_BLOCK = 128

N_EVEN = (DEPTH + 1) // 2
N_ODD = DEPTH // 2

kernel_name = 'hybrid_moba_gmlp_diffattn_macaron'


def rms_norm(x, g):
    xf = x.astype(jnp.float32)
    y = xf * lax.rsqrt(jnp.mean(xf * xf, axis=-1, keepdims=True) + NORM_EPS)
    return (y * g.astype(jnp.float32)).astype(x.dtype)


def layer_norm(x, g, b):
    xf = x.astype(jnp.float32)
    mu = jnp.mean(xf, axis=-1, keepdims=True)
    var = jnp.mean(jnp.square(xf - mu), axis=-1, keepdims=True)
    y = (xf - mu) * lax.rsqrt(var + NORM_EPS)
    return (y * g.astype(jnp.float32) + b.astype(jnp.float32)).astype(x.dtype)


def swiglu(x, w_gate, w_up, w_down):
    return (jax.nn.silu(x @ w_gate) * (x @ w_up)) @ w_down


def rope_tables(seq_len):
    inv = 1.0 / (ROPE_THETA ** (jnp.arange(0, ROT_DIM, 2, dtype=jnp.float32) / ROT_DIM))
    ang = jnp.arange(seq_len, dtype=jnp.float32)[:, None] * inv[None, :]
    return jnp.cos(ang), jnp.sin(ang)


def apply_partial_rope(x, cos, sin):
    half = ROT_DIM // 2
    x1, x2, rest = x[..., :half], x[..., half:ROT_DIM], x[..., ROT_DIM:]
    c, s = cos.astype(x.dtype), sin.astype(x.dtype)
    return jnp.concatenate([x1 * c - x2 * s, x1 * s + x2 * c, rest], axis=-1)


_gather_blocks = jax.vmap(jax.vmap(lambda tab, idx: tab[idx]))


def moba_attention(q, k, v):
    B, H, S, Dh = q.shape
    s_pad = -(-S // MOBA_BLOCK) * MOBA_BLOCK
    pad = ((0, 0), (0, 0), (0, s_pad - S), (0, 0))
    q, k, v = jnp.pad(q, pad), jnp.pad(k, pad), jnp.pad(v, pad)
    n_blocks = s_pad // MOBA_BLOCK
    kb = k.reshape(B, H, n_blocks, MOBA_BLOCK, Dh)
    vb = v.reshape(B, H, n_blocks, MOBA_BLOCK, Dh)
    k_mean = jnp.mean(kb.astype(jnp.float32), axis=3).astype(q.dtype)
    scale = Dh ** -0.5
    n_top = min(MOBA_TOPK, n_blocks - 1)
    block_ids = jnp.arange(n_blocks)

    def chunk(c):
        start = c * MOBA_Q_CHUNK
        blk = start // MOBA_BLOCK
        qc = lax.dynamic_slice_in_dim(q, start, MOBA_Q_CHUNK, axis=2)
        q_pos = start + jnp.arange(MOBA_Q_CHUNK)
        k_pos = blk * MOBA_BLOCK + jnp.arange(MOBA_BLOCK)
        k_own = lax.dynamic_index_in_dim(kb, blk, axis=2, keepdims=False)
        v_own = lax.dynamic_index_in_dim(vb, blk, axis=2, keepdims=False)
        s_own = jnp.einsum('bhqd,bhkd->bhqk', qc, k_own).astype(jnp.float32) * scale
        s_own = jnp.where(k_pos[None, :] <= q_pos[:, None], s_own, -jnp.inf)
        if n_top == 0:
            p_own = jax.nn.softmax(s_own, axis=-1).astype(v.dtype)
            return jnp.einsum('bhqk,bhkd->bhqd', p_own, v_own)
        gate = jnp.einsum('bhqd,bhnd->bhqn', qc, k_mean).astype(jnp.float32)
        gate = jnp.where(block_ids < blk, gate, -jnp.inf)
        _, idx = lax.top_k(gate, n_top)
        valid = idx < blk
        k_sel = _gather_blocks(kb, idx)
        v_sel = _gather_blocks(vb, idx)
        s_sel = jnp.einsum('bhqd,bhqnkd->bhqnk', qc, k_sel).astype(jnp.float32) * scale
        s_sel = jnp.where(valid[..., None], s_sel, -jnp.inf)
        scores = jnp.concatenate(
            [s_sel.reshape(B, H, MOBA_Q_CHUNK, n_top * MOBA_BLOCK), s_own], axis=-1)
        p = jax.nn.softmax(scores, axis=-1).astype(v.dtype)
        p_sel = p[..., :n_top * MOBA_BLOCK].reshape(B, H, MOBA_Q_CHUNK, n_top, MOBA_BLOCK)
        p_own = p[..., n_top * MOBA_BLOCK:]
        return (jnp.einsum('bhqnk,bhqnkd->bhqd', p_sel, v_sel)
                + jnp.einsum('bhqk,bhkd->bhqd', p_own, v_own))

    n_chunks = s_pad // MOBA_Q_CHUNK
    out = lax.map(chunk, jnp.arange(n_chunks))
    out = out.transpose(1, 2, 0, 3, 4).reshape(B, H, s_pad, Dh)
    return out[:, :, :S]


def chunked_spatial_gating(z, ln_g, ln_b, w_s, b_s):
    B, S, _ = z.shape
    u, v = z[..., :GMLP_WIDTH], z[..., GMLP_WIDTH:]
    v = layer_norm(v.reshape(B, S, GMLP_GROUPS, GMLP_GROUP_DIM), ln_g, ln_b)
    v = v.reshape(B, S // GMLP_CHUNK, GMLP_CHUNK, GMLP_GROUPS, GMLP_GROUP_DIM)
    causal = jnp.tril(jnp.ones((GMLP_CHUNK, GMLP_CHUNK), dtype=bool))
    w = jnp.where(causal[None], w_s, jnp.zeros_like(w_s))
    mixed = jnp.einsum('gts,bnsgd->bntgd', w, v) + b_s.T[None, None, :, :, None]
    return u * mixed.reshape(B, S, GMLP_WIDTH)


def diff_attention(q, k, v, lam, subln_g, lambda_init):
    B, H, _, S, Dqk = q.shape
    scale = Dqk ** -0.5
    k_pos = jnp.arange(S)

    def block(i):
        start = i * DIFF_Q_BLOCK
        qb = lax.dynamic_slice_in_dim(q, start, DIFF_Q_BLOCK, axis=3)
        s = jnp.einsum('bhcqd,bhckd->bhcqk', qb, k).astype(jnp.float32) * scale
        q_pos = start + jnp.arange(DIFF_Q_BLOCK)
        s = jnp.where(k_pos[None, :] <= q_pos[:, None], s, -jnp.inf)
        p = jax.nn.softmax(s, axis=-1)
        a = (p[:, :, 0] - lam * p[:, :, 1]).astype(v.dtype)
        o = jnp.einsum('bhqk,bhkd->bhqd', a, v)
        return rms_norm(o, subln_g) * (1.0 - lambda_init)

    out = lax.map(block, jnp.arange(S // DIFF_Q_BLOCK))
    return out.transpose(1, 0, 3, 2, 4).reshape(B, S, H * v.shape[-1])


def even_mixer(h, cos, sin, w_in, w_out, ln_g, ln_b, w_s, b_s):
    B, S, _ = h.shape
    z = h @ w_in
    q = z[..., :MOBA_WIDTH]
    k = z[..., MOBA_WIDTH:2 * MOBA_WIDTH]
    v = z[..., 2 * MOBA_WIDTH:3 * MOBA_WIDTH]
    gz = z[..., 3 * MOBA_WIDTH:]
    to_heads = lambda t: t.reshape(B, S, MOBA_HEADS, HEAD_DIM).transpose(0, 2, 1, 3)
    q = apply_partial_rope(to_heads(q), cos, sin)
    k = apply_partial_rope(to_heads(k), cos, sin)
    attn = moba_attention(q, k, to_heads(v))
    attn = attn.transpose(0, 2, 1, 3).reshape(B, S, MOBA_WIDTH)
    gated = chunked_spatial_gating(jax.nn.gelu(gz), ln_g, ln_b, w_s, b_s)
    return jnp.concatenate([attn, gated], axis=-1) @ w_out


def odd_mixer(h, cos, sin, w_in, w_out, lq1, lk1, lq2, lk2, subln_g, lambda_init):
    B, S, _ = h.shape
    z = h @ w_in
    to_qk = lambda t: t.reshape(B, S, DIFF_HEADS, 2, DIFF_QK_DIM).transpose(0, 2, 3, 1, 4)
    q = apply_partial_rope(to_qk(z[..., :DIFF_QK_WIDTH]), cos, sin)
    k = apply_partial_rope(to_qk(z[..., DIFF_QK_WIDTH:2 * DIFF_QK_WIDTH]), cos, sin)
    v = z[..., 2 * DIFF_QK_WIDTH:].reshape(B, S, DIFF_HEADS, DIFF_V_DIM).transpose(0, 2, 1, 3)
    f32 = jnp.float32
    lam = (jnp.exp(jnp.sum(lq1.astype(f32) * lk1.astype(f32)))
           - jnp.exp(jnp.sum(lq2.astype(f32) * lk2.astype(f32))) + lambda_init)
    return diff_attention(q, k, v, lam, subln_g, lambda_init) @ w_out


def setup_inputs(seed: int = 0) -> dict:
    key = jax.random.key(seed)
    ks = iter(jax.random.split(key, 32))
    nrm = lambda shape, scale: jax.random.normal(next(ks), shape, jnp.float32) * scale
    gain = lambda shape: 1.0 + nrm(shape, 0.02)
    return {
        'x': nrm((BATCH, SEQ, D_MODEL), 1.0),
        'ffn_pre_norm': gain((DEPTH, D_MODEL)),
        'ffn_pre_w_gate': nrm((DEPTH, D_MODEL, D_FF), D_MODEL ** -0.5),
        'ffn_pre_w_up': nrm((DEPTH, D_MODEL, D_FF), D_MODEL ** -0.5),
        'ffn_pre_w_down': nrm((DEPTH, D_FF, D_MODEL), D_FF ** -0.5),
        'mix_norm': gain((DEPTH, D_MODEL)),
        'ffn_post_norm': gain((DEPTH, D_MODEL)),
        'ffn_post_w_gate': nrm((DEPTH, D_MODEL, D_FF), D_MODEL ** -0.5),
        'ffn_post_w_up': nrm((DEPTH, D_MODEL, D_FF), D_MODEL ** -0.5),
        'ffn_post_w_down': nrm((DEPTH, D_FF, D_MODEL), D_FF ** -0.5),
        'even_w_in': nrm((N_EVEN, D_MODEL, EVEN_IN), D_MODEL ** -0.5),
        'even_w_out': nrm((N_EVEN, EVEN_OUT, D_MODEL), EVEN_OUT ** -0.5),
        'gmlp_ln_g': gain((N_EVEN, GMLP_GROUPS, GMLP_GROUP_DIM)),
        'gmlp_ln_b': nrm((N_EVEN, GMLP_GROUPS, GMLP_GROUP_DIM), 0.02),
        'gmlp_w_s': nrm((N_EVEN, GMLP_GROUPS, GMLP_CHUNK, GMLP_CHUNK), GMLP_CHUNK ** -0.5),
        'gmlp_b_s': 1.0 + nrm((N_EVEN, GMLP_GROUPS, GMLP_CHUNK), 0.02),
        'odd_w_in': nrm((N_ODD, D_MODEL, ODD_IN), D_MODEL ** -0.5),
        'odd_w_out': nrm((N_ODD, DIFF_WIDTH, D_MODEL), DIFF_WIDTH ** -0.5),
        'diff_lambda_q1': nrm((N_ODD, DIFF_QK_DIM), 0.1),
        'diff_lambda_k1': nrm((N_ODD, DIFF_QK_DIM), 0.1),
        'diff_lambda_q2': nrm((N_ODD, DIFF_QK_DIM), 0.1),
        'diff_lambda_k2': nrm((N_ODD, DIFF_QK_DIM), 0.1),
        'diff_subln_g': gain((N_ODD, DIFF_V_DIM)),
        'final_norm': gain((D_MODEL,)),
    }


def reference(x, ffn_pre_norm, ffn_pre_w_gate, ffn_pre_w_up, ffn_pre_w_down, mix_norm,
              ffn_post_norm, ffn_post_w_gate, ffn_post_w_up, ffn_post_w_down,
              even_w_in, even_w_out, gmlp_ln_g, gmlp_ln_b, gmlp_w_s, gmlp_b_s,
              odd_w_in, odd_w_out, diff_lambda_q1, diff_lambda_k1, diff_lambda_q2,
              diff_lambda_k2, diff_subln_g, final_norm):
    cos, sin = rope_tables(x.shape[1])
    for layer in range(DEPTH):
        x = x + 0.5 * swiglu(rms_norm(x, ffn_pre_norm[layer]), ffn_pre_w_gate[layer],
                             ffn_pre_w_up[layer], ffn_pre_w_down[layer])
        h = rms_norm(x, mix_norm[layer])
        if layer % 2 == 0:
            e = layer // 2
            x = x + even_mixer(h, cos, sin, even_w_in[e], even_w_out[e], gmlp_ln_g[e],
                               gmlp_ln_b[e], gmlp_w_s[e], gmlp_b_s[e])
        else:
            o = layer // 2
            lambda_init = 0.8 - 0.6 * math.exp(-0.3 * layer)
            x = x + odd_mixer(h, cos, sin, odd_w_in[o], odd_w_out[o], diff_lambda_q1[o],
                              diff_lambda_k1[o], diff_lambda_q2[o], diff_lambda_k2[o],
                              diff_subln_g[o], lambda_init)
        x = x + 0.5 * swiglu(rms_norm(x, ffn_post_norm[layer]), ffn_post_w_gate[layer],
                             ffn_post_w_up[layer], ffn_post_w_down[layer])
    return rms_norm(x, final_norm)
```

```cpp
#include <hip/hip_runtime.h>
#include <hip/hip_cooperative_groups.h>
#include <hip/hip_bf16.h>
#include <cstdio>
#include <cstdint>
#include <cmath>
__device__ __forceinline__ int mk_lane(){ int l_; asm volatile("v_mbcnt_lo_u32_b32 %0, -1, 0\n\tv_mbcnt_hi_u32_b32 %0, -1, %0" : "=v"(l_)); return l_; }
namespace pg8 {
#define PG8_LAS __attribute__((address_space(3)))
typedef unsigned short bf16_t;
typedef short bf16x8 __attribute__((ext_vector_type(8)));
typedef float f32x4 __attribute__((ext_vector_type(4)));
typedef unsigned u32x4 __attribute__((ext_vector_type(4)));
constexpr int BM = 256, BK = 64, HALF = 128, HTB = HALF * BK * 2  , STAGE_BYTES = 8 * HTB, NXCD = 8, WGM = 8;

__host__ __device__ __forceinline__ int lds_byte(int r, int c) { const int st = (r >> 4) * 2 + (c >> 5), rr = r & 15, cc = c & 31, ob = rr * 64 + cc * 2; return st * 1024 + (ob ^ (((ob >> 9) & 1) << 5)); }
__host__ __device__ __forceinline__ void stage_rc(int b, int& R, int& C) { const int st = b / 1024, sb = b % 1024, swz = sb ^ (((sb >> 9) & 1) << 5); R = (st >> 1) * 16 + swz / 64; C = (st & 1) * 32 + (swz % 64) / 2; }
__host__ __device__ __forceinline__ int perm32(int rho) { const int n = rho >> 4, i = rho & 15; return 8 * (i >> 2) + 4 * n + (i & 3); }

struct Unit { int pm, pn; };
struct Gemm { const bf16_t* A; const bf16_t* Bt; int M, N, K; };

struct StaticOrder {
    int nM, nN, nwg, G, c;
    __host__ __device__ void init(int M, int N, int G_, int c_) { nM = M / BM; nN = N / BM; nwg = nM * nN; G = G_; c = c_; }
    __host__ __device__ bool next(int i, Unit& u) const {
        const long L = (long)i * G + c; if (L >= nwg) return false;
        int wgid = (int)L; { const int q = nwg / NXCD, r = nwg % NXCD, xcd = wgid % NXCD, off = wgid / NXCD; wgid = (xcd < r ? xcd * (q + 1) : r * (q + 1) + (xcd - r) * q) + off; }
        const int nig = WGM * nN, gid = wgid / nig, fm = gid * WGM, gsz = (nM - fm) < WGM ? (nM - fm) : WGM;
        u.pm = fm + ((wgid % nig) % gsz); u.pn = (wgid % nig) / gsz; return true;
    }
    __device__ __forceinline__ void a_ready(const Unit&) const {}
    __device__ __forceinline__ void done(const Unit&) const {}
};

__device__ __forceinline__ unsigned cvt_pk_bf16(float lo, float hi) { unsigned r; asm volatile("v_cvt_pk_bf16_f32 %0, %1, %2" : "=v"(r) : "v"(lo), "v"(hi)); return r; }
typedef float f32x2 __attribute__((ext_vector_type(2)));
__device__ __forceinline__ f32x2 gelu_pk(f32x2 v) {
    const f32x2 av = __builtin_elementwise_abs(v), d = av * 0.2316418882f + 1.0f;
    f32x2 t; t.x = __builtin_amdgcn_rcpf(d.x); t.y = __builtin_amdgcn_rcpf(d.y);
    f32x2 q = t * 0.5307027145f + (-0.7265760135f); q = q * t + 0.7107068705f; q = q * t + (-0.142248368f); q = q * t + 0.127414796f; q = q * t;
    const f32x2 s = (v * v) * (-0.72134752044f);
    f32x2 e; e.x = __builtin_amdgcn_exp2f(s.x); e.y = __builtin_amdgcn_exp2f(s.y);
    const f32x2 m = v * (q * e), r = v - m;
    f32x2 o; o.x = v.x < 0.f ? m.x : r.x; o.y = v.y < 0.f ? m.y : r.y; return o;
}

template <int ACT  > struct EpiBf16 {
    static constexpr bool PERM = true, AFTER_DRAIN = false; static_assert(ACT == 0 || ACT == 1, "EpiBf16: ACT is 0 (none) or 1 (gelu_pk)");
    bf16_t* O; int ldc; const float* bias; int split_cols; size_t split_stride; float scale0;
    __device__ __forceinline__ void operator()(const f32x4 (&acc)[2][2][4][2], const Unit& u, int wr, int wc, int fr, int fq) const {
        const int row0 = u.pm * BM + wr * 64 + fr; int colt = u.pn * BM; bf16_t* base = O;
        float sc = 1.f; if (split_cols) { const int t = colt / split_cols; base += (size_t)t * split_stride; colt -= t * split_cols; if (t == 0) sc = scale0; }
        const int col0 = colt + wc * 32 + 8 * fq, bcol0 = u.pn * BM + wc * 32 + 8 * fq;
        f32x4 bv[2][2];
#pragma unroll
        for (int bj = 0; bj < 2; ++bj)
#pragma unroll
            for (int n = 0; n < 2; ++n) bv[bj][n] = bias ? *(const f32x4*)(bias + bcol0 + bj * HALF + 4 * n) : (f32x4){0.f, 0.f, 0.f, 0.f};
#pragma unroll
        for (int ai = 0; ai < 2; ++ai)
#pragma unroll
            for (int m = 0; m < 4; ++m) { bf16_t* rowp = base + (size_t)(row0 + ai * HALF + m * 16) * ldc + col0;
#pragma unroll
                for (int bj = 0; bj < 2; ++bj) { f32x4 v0 = acc[ai][bj][m][0] + bv[bj][0], v1 = acc[ai][bj][m][1] + bv[bj][1];
                    if (ACT == 1) { f32x2 a = gelu_pk((f32x2){v0[0], v0[1]}), b = gelu_pk((f32x2){v0[2], v0[3]}), c = gelu_pk((f32x2){v1[0], v1[1]}), d = gelu_pk((f32x2){v1[2], v1[3]});
                        v0 = (f32x4){a.x, a.y, b.x, b.y}; v1 = (f32x4){c.x, c.y, d.x, d.y}; }
                    v0 = v0 * sc; v1 = v1 * sc; u32x4 w; w.x = cvt_pk_bf16(v0[0], v0[1]); w.y = cvt_pk_bf16(v0[2], v0[3]); w.z = cvt_pk_bf16(v1[0], v1[1]); w.w = cvt_pk_bf16(v1[2], v1[3]);
                    *(u32x4*)(rowp + bj * HALF) = w; } }
    }
};

typedef unsigned u32x2 __attribute__((ext_vector_type(2)));
constexpr int SLOTS = 16;
constexpr float RMS_EPS = 1e-6f;
__device__ __forceinline__ void load_rstd(const float* ss, int row0, int fq, float (&rs)[2][4]) {
#pragma unroll
    for (int ai = 0; ai < 2; ++ai)
#pragma unroll
        for (int m = 0; m < 4; ++m) { const f32x4 a = *(const f32x4*)(ss + (size_t)(row0 + ai * HALF + m * 16) * SLOTS + 4 * fq);
            float s = (a[0] + a[1]) + (a[2] + a[3]); s += __shfl_xor(s, 16); s += __shfl_xor(s, 32);
            rs[ai][m] = __builtin_amdgcn_rsqf(s * (1.0f / 1024.0f) + RMS_EPS); }
}
__device__ __forceinline__ float silu_f(float g) { return g * __builtin_amdgcn_rcpf(1.0f + __builtin_amdgcn_exp2f(-1.4426950408889634f * g)); }
__device__ __forceinline__ float gelu_t(float x) { const float y = x * (1.0f + 0.044715f * x * x); return x * __builtin_amdgcn_rcpf(1.0f + __builtin_amdgcn_exp2f(-2.302208198f * y)); }

typedef float f32x2 __attribute__((ext_vector_type(2)));
__device__ __forceinline__ f32x2 swiglu_pk(f32x2 g, f32x2 u, f32x2 r2, f32x2 c2) {
    const f32x2 t = g * c2, gg = g * r2, uu = u * r2; f32x2 e; e.x = __builtin_amdgcn_exp2f(t.x); e.y = __builtin_amdgcn_exp2f(t.y);
    const f32x2 d = e + 1.0f; f32x2 sg; sg.x = __builtin_amdgcn_rcpf(d.x); sg.y = __builtin_amdgcn_rcpf(d.y);
    return (gg * sg) * uu;
}
struct EpiSwiglu {
    static constexpr bool PERM = true, AFTER_DRAIN = false;
    bf16_t* H; int ldh; const float* ss;
    __device__ __forceinline__ void operator()(const f32x4 (&acc)[2][2][4][2], const Unit& u, int wr, int wc, int fr, int fq) const {
        const int row0 = u.pm * BM + wr * 64 + fr; float rs[2][4]; load_rstd(ss, row0, fq, rs);
        const int col0 = u.pn * HALF + wc * 32 + 8 * fq;
#pragma unroll
        for (int ai = 0; ai < 2; ++ai)
#pragma unroll
            for (int m = 0; m < 4; ++m) { const float r = rs[ai][m]; bf16_t* p = H + (size_t)(row0 + ai * HALF + m * 16) * ldh + col0;
                const f32x2 r2 = (f32x2){r, r}, c2 = r2 * (-1.4426950408889634f);
                const f32x4 g0 = acc[ai][0][m][0], g1 = acc[ai][0][m][1], u0 = acc[ai][1][m][0], u1 = acc[ai][1][m][1];
                const f32x2 h0 = swiglu_pk((f32x2){g0[0], g0[1]}, (f32x2){u0[0], u0[1]}, r2, c2), h1 = swiglu_pk((f32x2){g0[2], g0[3]}, (f32x2){u0[2], u0[3]}, r2, c2);
                const f32x2 h2 = swiglu_pk((f32x2){g1[0], g1[1]}, (f32x2){u1[0], u1[1]}, r2, c2), h3 = swiglu_pk((f32x2){g1[2], g1[3]}, (f32x2){u1[2], u1[3]}, r2, c2);
                u32x4 w; w.x = cvt_pk_bf16(h0.x, h0.y); w.y = cvt_pk_bf16(h1.x, h1.y); w.z = cvt_pk_bf16(h2.x, h2.y); w.w = cvt_pk_bf16(h3.x, h3.y);
                *(u32x4*)p = w; }
    }
};
struct EpiResid {
    static constexpr bool PERM = true, AFTER_DRAIN = false;
    bf16_t* xb; float* ss; float alpha;
    __device__ __forceinline__ void operator()(const f32x4 (&acc)[2][2][4][2], const Unit& u, int wr, int wc, int fr, int fq) const {
        const int row0 = u.pm * BM + wr * 64 + fr, col0 = u.pn * BM + wc * 32 + 8 * fq;
#pragma unroll
        for (int ai = 0; ai < 2; ++ai)
#pragma unroll
            for (int m = 0; m < 4; ++m) { const int row = row0 + ai * HALF + m * 16; const size_t off = (size_t)row * 1024 + col0; float q = 0.f;
#pragma unroll
                for (int bj = 0; bj < 2; ++bj) { u32x4* p = (u32x4*)(xb + off + bj * HALF); const u32x4 bw = *p;
                    const f32x4 b0 = (f32x4){__builtin_bit_cast(float, bw.x << 16), __builtin_bit_cast(float, bw.x & 0xffff0000u), __builtin_bit_cast(float, bw.y << 16), __builtin_bit_cast(float, bw.y & 0xffff0000u)};
                    const f32x4 b1 = (f32x4){__builtin_bit_cast(float, bw.z << 16), __builtin_bit_cast(float, bw.z & 0xffff0000u), __builtin_bit_cast(float, bw.w << 16), __builtin_bit_cast(float, bw.w & 0xffff0000u)};
                    const f32x4 o0 = b0 + acc[ai][bj][m][0] * alpha, o1 = b1 + acc[ai][bj][m][1] * alpha;
                    q += ((o0[0] * o0[0] + o0[1] * o0[1]) + (o0[2] * o0[2] + o0[3] * o0[3])) + ((o1[0] * o1[0] + o1[1] * o1[1]) + (o1[2] * o1[2] + o1[3] * o1[3]));
                    u32x4 w; w.x = cvt_pk_bf16(o0[0], o0[1]); w.y = cvt_pk_bf16(o0[2], o0[3]); w.z = cvt_pk_bf16(o1[0], o1[1]); w.w = cvt_pk_bf16(o1[2], o1[3]); *p = w; }
                q += __shfl_xor(q, 16); q += __shfl_xor(q, 32);
                if (fq == 0) ss[(size_t)row * SLOTS + u.pn * 4 + wc] = q;
                if (m & 1) asm volatile("" ::: "memory"); }
    }
};
struct EpiIn {
    static constexpr bool PERM = true, AFTER_DRAIN = false;
    bf16_t* dst; size_t sec_stride; int ntq; const float* ss; const float* rope; float* kmean; float qscale;
    __device__ __forceinline__ void operator()(const f32x4 (&acc)[2][2][4][2], const Unit& u, int wr, int wc, int fr, int fq) const {
        const int sec = u.pn / ntq, tcol = (u.pn - sec * ntq) * BM, pitch = ntq * BM;
        bf16_t* basep = dst + (size_t)sec * sec_stride;
        const int row0 = u.pm * BM + wr * 64 + fr; float rs[2][4]; load_rstd(ss, row0, fq, rs);
        const int col0 = tcol + wc * 32 + 8 * fq;
        const bool ropelane = (sec < 2) && ((wc & 1) == 0) && (fq < 2);
        const float qs = (sec == 0) ? qscale : 1.0f;
        const bool dokm = (sec == 1) && (kmean != nullptr);
        f32x4 ks[2][2];
#pragma unroll
        for (int bj = 0; bj < 2; ++bj)
#pragma unroll
            for (int n = 0; n < 2; ++n) ks[bj][n] = (f32x4){0.f, 0.f, 0.f, 0.f};
#pragma unroll
        for (int ai = 0; ai < 2; ++ai) {
            f32x4 csv[4][2];
#pragma unroll
            for (int m = 0; m < 4; ++m) { csv[m][0] = (f32x4){1.f, 0.f, 1.f, 0.f}; csv[m][1] = csv[m][0];
                if (ropelane) { const float* rp = rope + ((size_t)((row0 + ai * HALF + m * 16) & 8191) * 8 + 4 * fq) * 2; csv[m][0] = *(const f32x4*)rp; csv[m][1] = *(const f32x4*)(rp + 4); } }
#pragma unroll
            for (int m = 0; m < 4; ++m) { const int row = row0 + ai * HALF + m * 16; const float r = rs[ai][m]; bf16_t* rowp = basep + (size_t)row * pitch + col0;
                const f32x4 cs0 = csv[m][0], cs1 = csv[m][1];
#pragma unroll
                for (int bj = 0; bj < 2; ++bj) { f32x4 v0 = acc[ai][bj][m][0] * r, v1 = acc[ai][bj][m][1] * r;
                    if (sec < 2) {
                        if (ropelane) {
                            const f32x4 a = v0, b = v1;
                            v0 = (f32x4){a[0] * cs0[0] - a[1] * cs0[1], a[0] * cs0[1] + a[1] * cs0[0], a[2] * cs0[2] - a[3] * cs0[3], a[2] * cs0[3] + a[3] * cs0[2]};
                            v1 = (f32x4){b[0] * cs1[0] - b[1] * cs1[1], b[0] * cs1[1] + b[1] * cs1[0], b[2] * cs1[2] - b[3] * cs1[3], b[2] * cs1[3] + b[3] * cs1[2]};
                        }
                        v0 = v0 * qs; v1 = v1 * qs;
                        if (dokm) { ks[bj][0] += v0; ks[bj][1] += v1; }
                    } else if (sec >= 3) {
                        v0 = (f32x4){gelu_t(v0[0]), gelu_t(v0[1]), gelu_t(v0[2]), gelu_t(v0[3])}; v1 = (f32x4){gelu_t(v1[0]), gelu_t(v1[1]), gelu_t(v1[2]), gelu_t(v1[3])};
                    }
                    u32x4 w; w.x = cvt_pk_bf16(v0[0], v0[1]); w.y = cvt_pk_bf16(v0[2], v0[3]); w.z = cvt_pk_bf16(v1[0], v1[1]); w.w = cvt_pk_bf16(v1[2], v1[3]);
                    *(u32x4*)(rowp + bj * HALF) = w; } }
            asm volatile("" ::: "memory"); }
        if (dokm) {
#pragma unroll
            for (int bj = 0; bj < 2; ++bj)
#pragma unroll
                for (int n = 0; n < 2; ++n)
#pragma unroll
                    for (int j = 0; j < 4; ++j) { float s = ks[bj][n][j]; s += __shfl_xor(s, 1); s += __shfl_xor(s, 2); s += __shfl_xor(s, 4); s += __shfl_xor(s, 8);
                        if (fr == 0) atomicAdd(kmean + (size_t)u.pm * 512 + col0 + bj * HALF + 4 * n + j, s * (1.0f / 256.0f)); }
        }
    }
};

template <class Epi, class Sched, bool ALIGN_EPI = false, bool SP2 = false>
__device__ __forceinline__ void gemm_phase(PG8_LAS unsigned char* lds, const Gemm g, const Sched& S, const Epi& E, const int wv_  ) {
    int tid_ = (mk_lane()+((wv_)<<6)); asm volatile("" : "+v"(tid_));
    const int tid = tid_, wid = __builtin_amdgcn_readfirstlane(tid >> 6), lane = tid & 63, wr = wid >> 2, wc = wid & 3, fr = lane & 15, fq = lane >> 4;
    const int K = g.K, nt = K / BK;
    unsigned voffA[2], voffB[2];
#pragma unroll
    for (int i = 0; i < 2; ++i) { int R, C; stage_rc(tid * 16 + i * 8192, R, C); const int Rb = Epi::PERM ? ((R & ~31) + perm32(R & 31)) : R;
        voffA[i] = (unsigned)(R * K + C) * 2u; voffB[i] = (unsigned)(Rb * K + C) * 2u; }
    const size_t kstep = (size_t)(BK * 2);
    const size_t hstep = (size_t)HALF * K * 2;
    const size_t tstep = 2 * hstep;
    const unsigned ldsw = (unsigned)wid * 1024u;
    const int aoff = lds_byte(wr * 64 + fr, fq * 8), boff = lds_byte(wc * 32 + fr, fq * 8);
#define PG8_SA(b, h) (((b) * 2 + (h)) * HTB)
#define PG8_SB(b, h) ((4 + (b) * 2 + (h)) * HTB)
#define PG8_STAGE(bufoff, gbase, voff) do { _Pragma("unroll") for (int _i = 0; _i < 2; ++_i) \
        __builtin_amdgcn_global_load_lds((const unsigned*)((const char*)(gbase) + (voff)[_i]), (PG8_LAS unsigned*)(lds + (bufoff) + ldsw + _i * 8192), 16, 0, 0); } while (0)
#define PG8_LDA(dst, b, h) do { _Pragma("unroll") for (int m = 0; m < 4; ++m) _Pragma("unroll") for (int k = 0; k < 2; ++k) dst[m][k] = *(const PG8_LAS bf16x8*)(lds + PG8_SA(b, h) + aoff + m * 2048 + k * 1024); } while (0)
#define PG8_LDB(dst, b, h) do { _Pragma("unroll") for (int n = 0; n < 2; ++n) _Pragma("unroll") for (int k = 0; k < 2; ++k) dst[n][k] = *(const PG8_LAS bf16x8*)(lds + PG8_SB(b, h) + boff + n * 2048 + k * 1024); } while (0)
#define PG8_MMA(ai, bj, At, Bt) do { __builtin_amdgcn_s_setprio(1); _Pragma("unroll") for (int m = 0; m < 4; ++m) _Pragma("unroll") for (int n = 0; n < 2; ++n) _Pragma("unroll") for (int k = 0; k < 2; ++k) \
        acc[ai][bj][m][n] = __builtin_amdgcn_mfma_f32_16x16x32_bf16(Bt[n][k], At[m][k], acc[ai][bj][m][n], 0, 0, 0); __builtin_amdgcn_s_setprio(0); } while (0)
#define PG8_WAIT_V(n) asm volatile("s_waitcnt vmcnt(" #n ")" ::: "memory")
#define PG8_WAIT_L(n) asm volatile("s_waitcnt lgkmcnt(" #n ")" ::: "memory")
#define PG8_BAR __builtin_amdgcn_s_barrier()
#define PG8_SCHED __builtin_amdgcn_sched_barrier(0)
    Unit cur, nxt; int ui = 0;
    if (!S.next(0, cur)) return;
    f32x4 acc[2][2][4][2];
#pragma unroll
    for (int a = 0; a < 2; ++a)
#pragma unroll
        for (int b = 0; b < 2; ++b)
#pragma unroll
            for (int m = 0; m < 4; ++m)
#pragma unroll
                for (int n = 0; n < 2; ++n) acc[a][b][m][n] = (f32x4){0.f, 0.f, 0.f, 0.f};
    bf16x8 At[4][2], B0[2][2], B1[2][2];
    const char* cA = (const char*)g.A + (size_t)cur.pm * tstep; const char* cB = (const char*)g.Bt + (size_t)cur.pn * tstep;
    S.a_ready(cur);
    if constexpr (SP2) {
        PG8_STAGE(PG8_SB(0, 0), cB, voffB); PG8_STAGE(PG8_SB(0, 1), cB + hstep, voffB); PG8_STAGE(PG8_SA(0, 0), cA, voffA); PG8_STAGE(PG8_SA(0, 1), cA + hstep, voffA);
        if (wr == 1) PG8_BAR;
        PG8_WAIT_V(2); PG8_BAR;
        PG8_STAGE(PG8_SB(1, 0), cB + kstep, voffB); PG8_STAGE(PG8_SA(1, 0), cA + kstep, voffA); PG8_STAGE(PG8_SB(1, 1), cB + hstep + kstep, voffB);
        PG8_WAIT_V(6); PG8_BAR;
    } else {
        PG8_STAGE(PG8_SB(0, 0), cB, voffB); PG8_STAGE(PG8_SA(0, 0), cA, voffA); PG8_STAGE(PG8_SB(0, 1), cB + hstep, voffB); PG8_STAGE(PG8_SA(0, 1), cA + hstep, voffA);
        if (wr == 1) PG8_BAR;
        PG8_WAIT_V(4); PG8_BAR;
        PG8_STAGE(PG8_SB(1, 0), cB + kstep, voffB); PG8_STAGE(PG8_SA(1, 0), cA + kstep, voffA); PG8_STAGE(PG8_SB(1, 1), cB + hstep + kstep, voffB);
        PG8_WAIT_V(6); PG8_BAR;
    }
    for (;;) {
        const bool has_next = S.next(ui + 1, nxt);
        const char* nA = has_next ? (const char*)g.A + (size_t)nxt.pm * tstep : cA; const char* nB = has_next ? (const char*)g.Bt + (size_t)nxt.pn * tstep : cB;
        for (int t = 0; t < nt; t += 2) {
            const bool last = (t == nt - 2);
            const char* a1 = cA + (size_t)(t + 1) * kstep;
            const char* a2 = last ? nA : cA + (size_t)(t + 2) * kstep; const char* b2 = last ? nB : cB + (size_t)(t + 2) * kstep;
            const char* a3 = a2 + kstep; const char* b3 = b2 + kstep;
            if (last && has_next) S.a_ready(nxt);
            if constexpr (SP2) {
            PG8_LDB(B0, 0, 0); PG8_LDB(B1, 0, 1); PG8_SCHED; PG8_LDA(At, 0, 0); PG8_STAGE(PG8_SA(1, 1), a1 + hstep, voffA);
            PG8_WAIT_V(8); PG8_WAIT_L(0); PG8_BAR; PG8_MMA(0, 0, At, B0); PG8_MMA(0, 1, At, B1); PG8_BAR; PG8_SCHED;
            PG8_LDA(At, 0, 1); PG8_STAGE(PG8_SB(0, 0), b2, voffB); PG8_STAGE(PG8_SB(0, 1), b2 + hstep, voffB); PG8_STAGE(PG8_SA(0, 0), a2, voffA);
            PG8_WAIT_V(8); PG8_WAIT_L(0); PG8_BAR; PG8_MMA(1, 0, At, B0); PG8_MMA(1, 1, At, B1); PG8_BAR; PG8_SCHED;
            PG8_LDB(B0, 1, 0); PG8_LDB(B1, 1, 1); PG8_SCHED; PG8_LDA(At, 1, 0); PG8_STAGE(PG8_SA(0, 1), a2 + hstep, voffA);
            PG8_WAIT_V(8); PG8_WAIT_L(0); PG8_BAR; PG8_MMA(0, 0, At, B0); PG8_MMA(0, 1, At, B1); PG8_BAR; PG8_SCHED;
            PG8_LDA(At, 1, 1); PG8_STAGE(PG8_SB(1, 0), b3, voffB); PG8_STAGE(PG8_SB(1, 1), b3 + hstep, voffB); PG8_STAGE(PG8_SA(1, 0), a3, voffA);
            PG8_WAIT_V(8); PG8_WAIT_L(0); PG8_BAR; PG8_MMA(1, 0, At, B0); PG8_MMA(1, 1, At, B1); PG8_BAR; PG8_SCHED;
            } else {
            PG8_LDB(B0, 0, 0); PG8_SCHED; PG8_LDA(At, 0, 0); PG8_STAGE(PG8_SA(1, 1), a1 + hstep, voffA);
            PG8_WAIT_L(8); PG8_BAR; PG8_WAIT_L(0); PG8_MMA(0, 0, At, B0); PG8_BAR; PG8_SCHED;
            PG8_LDB(B1, 0, 1); PG8_STAGE(PG8_SB(0, 0), b2, voffB);
            PG8_BAR; PG8_WAIT_L(0); PG8_MMA(0, 1, At, B1); PG8_BAR;
            PG8_LDA(At, 0, 1); PG8_STAGE(PG8_SA(0, 0), a2, voffA);
            PG8_BAR; PG8_WAIT_L(0); PG8_MMA(1, 0, At, B0); PG8_BAR; PG8_SCHED;
            PG8_STAGE(PG8_SB(0, 1), b2 + hstep, voffB);
            PG8_WAIT_V(6); PG8_BAR; PG8_MMA(1, 1, At, B1); PG8_BAR;
            PG8_LDB(B0, 1, 0); PG8_SCHED; PG8_LDA(At, 1, 0); PG8_STAGE(PG8_SA(0, 1), a2 + hstep, voffA);
            PG8_WAIT_L(8); PG8_BAR; PG8_WAIT_L(0); PG8_MMA(0, 0, At, B0); PG8_BAR; PG8_SCHED;
            PG8_LDB(B1, 1, 1); PG8_STAGE(PG8_SB(1, 0), b3, voffB);
            PG8_BAR; PG8_WAIT_L(0); PG8_MMA(0, 1, At, B1); PG8_BAR;
            PG8_LDA(At, 1, 1); PG8_STAGE(PG8_SA(1, 0), a3, voffA);
            PG8_BAR; PG8_WAIT_L(0); PG8_MMA(1, 0, At, B0); PG8_BAR; PG8_SCHED;
            PG8_STAGE(PG8_SB(1, 1), b3 + hstep, voffB);
            PG8_WAIT_V(6); PG8_BAR; PG8_MMA(1, 1, At, B1); PG8_BAR;
            }
        }
        if constexpr (ALIGN_EPI) { if (wr == 0) PG8_BAR; }
        if constexpr (!Epi::AFTER_DRAIN) { E(acc, cur, wr, wc, fr, fq); S.done(cur); }
        if (!has_next) break;
#pragma unroll
        for (int a = 0; a < 2; ++a)
#pragma unroll
            for (int b = 0; b < 2; ++b)
#pragma unroll
                for (int m = 0; m < 4; ++m)
#pragma unroll
                    for (int n = 0; n < 2; ++n) acc[a][b][m][n] = (f32x4){0.f, 0.f, 0.f, 0.f};
        cur = nxt; cA = nA; cB = nB; ++ui;
        if constexpr (ALIGN_EPI) { if (wr == 1) PG8_BAR; }
    }
    PG8_WAIT_V(0);
    if constexpr (!ALIGN_EPI) { if (wr == 0) PG8_BAR; }
    PG8_BAR;
    if constexpr (Epi::AFTER_DRAIN) { E.fused(acc, cur, wr, wc, fr, fq, lds, wid, lane); S.done(cur); }
#undef PG8_SA
#undef PG8_SB
#undef PG8_STAGE
#undef PG8_LDA
#undef PG8_LDB
#undef PG8_MMA
#undef PG8_WAIT_V
#undef PG8_WAIT_L
#undef PG8_BAR
#undef PG8_SCHED
}
}
namespace attn_body {
using bf16=__hip_bfloat16;
using bf16x8=__attribute__((ext_vector_type(8)))short;
using s16x4=__attribute__((ext_vector_type(4)))short;
using f32x16=__attribute__((ext_vector_type(16)))float;
using u32x4=__attribute__((ext_vector_type(4)))unsigned;
using f32x4m=__attribute__((ext_vector_type(4)))float;
constexpr int SEQ=8192,D=64;
constexpr int NW=8,QBLK=32,QB=QBLK*NW,KVBLK=64,NQB=SEQ/QB;

__device__ __forceinline__ int crow(int r,int hi){return (r&3)+8*(r>>2)+4*hi;}
#define SBAR() __builtin_amdgcn_sched_barrier(0)
__device__ __forceinline__ void cmask(f32x16&p0,f32x16&p1,int jb,int qrel,int hi){
  asm volatile("":"+v"(hi));
  const float NEG=-INFINITY; int kb=64*jb+4*hi;
  #pragma unroll
  for(int r=0;r<16;++r){int kv=kb+(r&3)+8*(r>>2); if(kv>qrel)p0[r]=NEG; if(kv+32>qrel)p1[r]=NEG;}
}

constexpr int NSLOT=3, SLOTB=8192;
constexpr int LDS_K=0, LDS_V=NSLOT*SLOTB, LDS_WS=2*NSLOT*SLOTB, LDS_OST=LDS_WS+NW*64*4, LDS_BYTES=LDS_OST+NW*4096;
constexpr float C2=0.125f*1.4426950408889634f;
__device__ __forceinline__ void glds16(const void*gsrc,unsigned lds_dst){unsigned keep;
  asm volatile("s_mov_b32 %0, m0\n\ts_mov_b32 m0, %2\n\ts_nop 0\n\tglobal_load_lds_dwordx4 %1, off\n\ts_mov_b32 m0, %0":"=&s"(keep):"v"(gsrc),"s"(lds_dst):"memory");}
__device__ __forceinline__ float max3f(float a,float b,float c){float r;asm("v_max3_f32 %0, %1, %2, %3":"=v"(r):"v"(a),"v"(b),"v"(c));return r;}
__device__ __forceinline__ float max2f(float a,float b){float r;asm("v_max_f32_e32 %0, %1, %2":"=v"(r):"v"(a),"v"(b));return r;}
__device__ __forceinline__ float fadd_s(float a,float b){float r;asm("v_add_f32_e32 %0, %1, %2":"=v"(r):"v"(a),"v"(b));return r;}
__device__ __forceinline__ float fsub_s(float a,float b){float r;asm("v_sub_f32_e32 %0, %1, %2":"=v"(r):"v"(a),"v"(b));return r;}
typedef float f32x2_t __attribute__((ext_vector_type(2))); typedef __bf16 bf16x2_t __attribute__((ext_vector_type(2)));
__device__ __forceinline__ unsigned cvtpk_s(float lo,float hi){f32x2_t v={lo,hi};bf16x2_t b=__builtin_convertvector(v,bf16x2_t);return __builtin_bit_cast(unsigned,b);}
#define WAIT_BAR(N) asm volatile("s_waitcnt vmcnt(" #N ") lgkmcnt(0)\n\ts_barrier":::"memory")

__device__ __forceinline__ void qkt(f32x16&p0,f32x16&p1,const char*Kslot,const bf16x8*qr,const f32x16&negm,int r32,int hi){
  const char*kb=Kslot+hi*1024+r32*16;
  #pragma unroll
  for(int d0=0;d0<4;++d0){
    const bf16x8 b0=*reinterpret_cast<const bf16x8*>(kb+d0*2048);
    const bf16x8 b1=*reinterpret_cast<const bf16x8*>(kb+d0*2048+512);
    if(d0==0){p0=__builtin_amdgcn_mfma_f32_32x32x16_bf16(b0,qr[0],negm,0,0,0);p1=__builtin_amdgcn_mfma_f32_32x32x16_bf16(b1,qr[0],negm,0,0,0);}
    else{p0=__builtin_amdgcn_mfma_f32_32x32x16_bf16(b0,qr[d0],p0,0,0,0);p1=__builtin_amdgcn_mfma_f32_32x32x16_bf16(b1,qr[d0],p1,0,0,0);}}
}
typedef __attribute__((address_space(3))) const char* lds_cptr;
typedef short v4i16_t __attribute__((ext_vector_type(4)));
__device__ __forceinline__ void kload8(bf16x8*kf,lds_cptr kp){
  kf[0]=*(const __attribute__((address_space(3))) bf16x8*)(kp);      kf[1]=*(const __attribute__((address_space(3))) bf16x8*)(kp+512);
  kf[2]=*(const __attribute__((address_space(3))) bf16x8*)(kp+2048); kf[3]=*(const __attribute__((address_space(3))) bf16x8*)(kp+2560);
  kf[4]=*(const __attribute__((address_space(3))) bf16x8*)(kp+4096); kf[5]=*(const __attribute__((address_space(3))) bf16x8*)(kp+4608);
  kf[6]=*(const __attribute__((address_space(3))) bf16x8*)(kp+6144); kf[7]=*(const __attribute__((address_space(3))) bf16x8*)(kp+6656);
}
__device__ __forceinline__ void kload2(bf16x8*kf,lds_cptr kp,int j){ kf[2*j]=*(const __attribute__((address_space(3))) bf16x8*)(kp+j*2048); kf[2*j+1]=*(const __attribute__((address_space(3))) bf16x8*)(kp+j*2048+512); }
__device__ __forceinline__ s16x4 vtr(lds_cptr p){ return __builtin_bit_cast(s16x4,__builtin_amdgcn_ds_read_tr16_b64_v4i16((__attribute__((address_space(3))) v4i16_t*)p)); }
__device__ __forceinline__ float rowmax(const f32x16&p0,const f32x16&p1){
  float a=max3f(p0[0],p0[1],p1[0]),b=max3f(p0[2],p0[3],p1[1]);a=max3f(a,p1[2],p1[3]);
  #pragma unroll
  for(int r=4;r<16;r+=4){a=max3f(a,p0[r],p0[r+1]);b=max3f(b,p0[r+2],p0[r+3]);a=max3f(a,p1[r],p1[r+1]);b=max3f(b,p1[r+2],p1[r+3]);}
  const float m=max2f(a,b);
  auto rr=__builtin_amdgcn_permlane32_swap(__float_as_uint(m),__float_as_uint(m),false,false);
  return max2f(__uint_as_float(rr[0]),__uint_as_float(rr[1]));
}
__device__ __forceinline__ void pv(f32x16*o,int vb,bf16x8 pa0,bf16x8 pa1,bf16x8 pa2,bf16x8 pa3){
  #pragma unroll
  for(int d0=0;d0<2;++d0){s16x4 lo[4],hi[4];
    #pragma unroll
    for(int ks=0;ks<4;++ks){
      asm volatile("ds_read_b64_tr_b16 %0,%1 offset:%c2":"=&v"(lo[ks]):"v"(vb),"i"(d0*4096+ks*1024):"memory");
      asm volatile("ds_read_b64_tr_b16 %0,%1 offset:%c2":"=&v"(hi[ks]):"v"(vb),"i"(d0*4096+ks*1024+512):"memory");}
    asm volatile("s_waitcnt lgkmcnt(0)":::"memory");SBAR();
    #define PK(k) (bf16x8){lo[k][0],lo[k][1],lo[k][2],lo[k][3],hi[k][0],hi[k][1],hi[k][2],hi[k][3]}
    o[d0]=__builtin_amdgcn_mfma_f32_32x32x16_bf16(pa0,PK(0),o[d0],0,0,0);
    o[d0]=__builtin_amdgcn_mfma_f32_32x32x16_bf16(pa1,PK(1),o[d0],0,0,0);
    o[d0]=__builtin_amdgcn_mfma_f32_32x32x16_bf16(pa2,PK(2),o[d0],0,0,0);
    o[d0]=__builtin_amdgcn_mfma_f32_32x32x16_bf16(pa3,PK(3),o[d0],0,0,0);
    #undef PK
  }
}

#ifndef ATTN_STORE16
#define ATTN_STORE16(p,v) (*(u32x4*)(p)=(v))
#endif
template<int THRL,int DM,int DMO,bool MOBA> __device__ __forceinline__ void attn_unit(int b,int hq,int hv,int qb,const bf16*Q,const bf16*__restrict__ K,const bf16*__restrict__ V,bf16*O,char*shm,const float*kmean,const int wv_){
  int tid=(mk_lane()+((wv_)<<6)); asm volatile("":"+v"(tid));
  const int lane=tid&63,r32=lane&31,hi=lane>>5; const int wid=__builtin_amdgcn_readfirstlane(tid>>6);
  const long rowbase=(long)b*SEQ; const int q0=qb*QB;
  const bf16*Qw=Q+(rowbase+q0+wid*QBLK)*DM+hq*D;
  const bf16*Kh=K+rowbase*DM+hq*D,*Vh=V+rowbase*DM+hv*D;
  const unsigned lds0=(unsigned)(uintptr_t)shm;
  float*wsf=(float*)(shm+LDS_WS)+wid*64;
  const bf16*ksrc=Kh+(long)lane*DM+wid*8;
  const bf16*vsrc=Vh+(long)(16*(wid&3)+(lane>>2))*DM+(wid>>2)*32+(lane&3)*8;
  const unsigned kdst=lds0+LDS_K+wid*1024, vdst=lds0+LDS_V+wid*1024;
  #define DMA_K(t,slot) glds16(ksrc+(long)(t)*KVBLK*DM,(unsigned)__builtin_amdgcn_readfirstlane(kdst+(slot)))
  #define DMA_V(t,slot) glds16(vsrc+(long)(t)*KVBLK*DM,(unsigned)__builtin_amdgcn_readfirstlane(vdst+(slot)))
  const int vb0=(int)(lds0+LDS_V)+((lane>>4)&1)*32+(lane&3)*8+(4*hi+((lane&15)>>2))*64;
  const char*Kbase=shm+LDS_K; bf16x8 kf[8];
  const lds_cptr shm3=(lds_cptr)shm; const lds_cptr kp0=shm3+LDS_K+hi*1024+r32*16; const lds_cptr vp0=shm3+LDS_V+((lane>>4)&1)*32+(lane&3)*8+(4*hi+((lane&15)>>2))*64;
  const int NT=(q0+QB)/KVBLK;
  DMA_K(0,0);DMA_V(0,0);DMA_K(1,SLOTB);
  bf16x8 qr[4];
  #pragma unroll
  for(int d0=0;d0<4;++d0)qr[d0]=*reinterpret_cast<const bf16x8*>(&Qw[(long)r32*DM+d0*16+hi*8]);
  unsigned selmask=0u;
  if constexpr(MOBA){ if(qb>0){
    const float*km=kmean+((size_t)(b*32+r32))*512+hq*64+hi*8;
    f32x16 g=f32x16{};
    #pragma unroll
    for(int d0=0;d0<4;++d0){ const f32x4m ka=*reinterpret_cast<const f32x4m*>(km+d0*16), kb=*reinterpret_cast<const f32x4m*>(km+d0*16+4);
      u32x4 w; w[0]=cvtpk_s(ka[0],ka[1]); w[1]=cvtpk_s(ka[2],ka[3]); w[2]=cvtpk_s(kb[0],kb[1]); w[3]=cvtpk_s(kb[2],kb[3]);
      g=__builtin_amdgcn_mfma_f32_32x32x16_bf16(__builtin_bit_cast(bf16x8,w),qr[d0],g,0,0,0); }
    int hi2=hi; asm volatile("":"+v"(hi2));
    float m1=-INFINITY,m2=-INFINITY,m3=-INFINITY;
    #define INS3(v_) do{ float t_=(v_); const float n1_=fmaxf(m1,t_); t_=fminf(m1,t_); m1=n1_; const float n2_=fmaxf(m2,t_); t_=fminf(m2,t_); m2=n2_; m3=fmaxf(m3,t_); }while(0)
    #pragma unroll
    for(int r=0;r<16;++r){ const int j=crow(r,hi2); const float v=(j<qb)?g[r]:-INFINITY; g[r]=v; INS3(v); }
    { auto x1=__builtin_amdgcn_permlane32_swap(__float_as_uint(m1),__float_as_uint(m1),false,false); auto x2=__builtin_amdgcn_permlane32_swap(__float_as_uint(m2),__float_as_uint(m2),false,false);
      auto x3=__builtin_amdgcn_permlane32_swap(__float_as_uint(m3),__float_as_uint(m3),false,false);
      m1=-INFINITY; m2=-INFINITY; m3=-INFINITY;
      INS3(__uint_as_float(x1[0])); INS3(__uint_as_float(x1[1])); INS3(__uint_as_float(x2[0])); INS3(__uint_as_float(x2[1])); INS3(__uint_as_float(x3[0])); INS3(__uint_as_float(x3[1])); }
    #undef INS3
    unsigned mk=0u;
    #pragma unroll
    for(int r=0;r<16;++r){ const int j=crow(r,hi2); if(j<qb && g[r]>=m3) mk|=(1u<<j); }
    { auto xm=__builtin_amdgcn_permlane32_swap(mk,mk,false,false); mk=xm[0]|xm[1]; }
    selmask=mk; } }
  #define MBIAS(P0,P1,t,band) do{ if constexpr(MOBA){ const float bs_=((band)||((selmask>>((t)>>2))&1u))?-mhat:-1e30f; _Pragma("unroll") for(int r=0;r<16;++r){P0[r]+=bs_;P1[r]+=bs_;} } }while(0)
  float mhat=0.f,l_reg=0.f;f32x16 o[2];o[0]=f32x16{};o[1]=f32x16{};f32x16 negm=f32x16{};if constexpr(!MOBA){asm volatile("":"+v"(negm));}
  const int qrel=wid*QBLK+r32;
  #define CMASK(P0,P1,t) do{int jb_=(t)-(NT-4); MBIAS(P0,P1,t,jb_>=0); if(jb_>=0)cmask(P0,P1,jb_,qrel,hi);}while(0)
  bool resc=false;
  #define START(P0,P1) do{ const float rm=rowmax(P0,P1); resc=false; \
    { const float dl=MOBA?__builtin_fmaxf(rm,-100.f):rm; mhat=fadd_s(mhat,dl); \
      _Pragma("unroll") for(int r=0;r<16;++r){P0[r]=fsub_s(P0[r],dl);P1[r]=fsub_s(P1[r],dl);} \
      if constexpr(!MOBA){ _Pragma("unroll") for(int r=0;r<16;++r)negm[r]=-mhat; asm volatile("":"+v"(negm)); } } \
    _Pragma("unroll") for(int r=0;r<16;++r)P0[r]=__builtin_amdgcn_exp2f(P0[r]); }while(0)
  #define RESC() do{ if(resc){ asm volatile("s_waitcnt lgkmcnt(0)":::"memory"); \
      _Pragma("unroll") for(int d_=0;d_<2;++d_) _Pragma("unroll") for(int r=0;r<16;++r)o[d_][r]*=wsf[crow(r,hi)]; } }while(0)
  f32x16 pA0,pA1,pB0,pB1;
  int sl_prev=0,sl_cur=0,sl_next=SLOTB;
  #define ROT() do{sl_prev=sl_cur;sl_cur=sl_next;sl_next=(sl_next==(NSLOT-1)*SLOTB)?0:sl_next+SLOTB;}while(0)
  DMA_K(2,2*SLOTB);
  WAIT_BAR(3);
  qkt(pA0,pA1,Kbase,qr,negm,r32,hi);asm volatile("s_nop 15\n\ts_nop 7":"+v"(pA0),"+v"(pA1));CMASK(pA0,pA1,0);
  START(pA0,pA1);
  _Pragma("unroll") for(int r=0;r<16;++r)pA1[r]=__builtin_amdgcn_exp2f(pA1[r]);
  WAIT_BAR(0);
  DMA_K(3,0);DMA_V(1,SLOTB);
  ROT();
  kload8(kf,kp0+sl_cur);
  WAIT_BAR(2);
  s16x4 vlo[8],vhi[8]; u32x4 pw0,pw1,pw2,pw3;
  #define PKW(P,B) cvtpk_s(P[B],P[B+1])
  #define PAF(k) __builtin_bit_cast(bf16x8,pw##k)
  #define VFR(i) (bf16x8){vlo[i][0],vlo[i][1],vlo[i][2],vlo[i][3],vhi[i][0],vhi[i][1],vhi[i][2],vhi[i][3]}
  #define PIN(x) asm volatile("":"+v"(x))
  #define MX3(a,b,c) __builtin_fmaxf(__builtin_fmaxf((a),(b)),(c))
  #define GAPA(MF,A0,A1,A2,A3,W0,W1,PW) do{ MF; sacc+=A0; sacc+=A1; sacc+=A2; sacc+=A3; PIN(sacc); W0; W1; PIN(PW); SBAR(); }while(0)
  #define EX(v) __builtin_amdgcn_exp2f(v)
  #define GAPB(MF,X,B) do{ MF; X[B]=EX(X[B]); X[B+1]=EX(X[B+1]); X[B+2]=EX(X[B+2]); X[B+3]=EX(X[B+3]); PIN(X); SBAR(); }while(0)
  #define VRD(i) do{ vlo[i]=vtr(vp_+(((i)>>2)*4096+((i)&3)*1024)); vhi[i]=vtr(vp_+(((i)>>2)*4096+((i)&3)*1024+512)); }while(0)
  #define KRD(G,j) do{ if(G){ kload2(kf,kp0+sl_next,j); SBAR(); } }while(0)
  #define STEP(C0,C1,P0,P1,t,GK,GV,GL) do{ SBAR(); \
    const lds_cptr vp_=vp0+sl_prev; \
    VRD(0); SBAR(); float sacc=(P0[0]+P0[1]); \
    GAPA(C0=__builtin_amdgcn_mfma_f32_32x32x16_bf16(kf[0],qr[0],negm,0,0,0), P0[2],P0[3],P0[4],P0[5],     pw0[0]=PKW(P0,0), pw0[1]=PKW(P0,2), pw0); \
    VRD(4); SBAR(); GAPA(C1=__builtin_amdgcn_mfma_f32_32x32x16_bf16(kf[1],qr[0],negm,0,0,0), P0[6],P0[7],P0[8],P0[9],     pw0[2]=PKW(P0,4), pw0[3]=PKW(P0,6), pw0); \
    VRD(1); SBAR(); GAPA(C0=__builtin_amdgcn_mfma_f32_32x32x16_bf16(kf[2],qr[1],C0,0,0,0),   P0[10],P0[11],P0[12],P0[13], pw1[0]=PKW(P0,8), pw1[1]=PKW(P0,10), pw1); \
    VRD(5); SBAR(); GAPA(C1=__builtin_amdgcn_mfma_f32_32x32x16_bf16(kf[3],qr[1],C1,0,0,0),   P0[14],P0[15],P1[0],P1[1],   pw1[2]=PKW(P0,12),pw1[3]=PKW(P0,14), pw1); \
    VRD(2); SBAR(); GAPA(C0=__builtin_amdgcn_mfma_f32_32x32x16_bf16(kf[4],qr[2],C0,0,0,0),   P1[2],P1[3],P1[4],P1[5],     pw2[0]=PKW(P1,0), pw2[1]=PKW(P1,2), pw2); \
    VRD(6); SBAR(); GAPA(C1=__builtin_amdgcn_mfma_f32_32x32x16_bf16(kf[5],qr[2],C1,0,0,0),   P1[6],P1[7],P1[8],P1[9],     pw2[2]=PKW(P1,4), pw2[3]=PKW(P1,6), pw2); \
    VRD(3); SBAR(); GAPA(C0=__builtin_amdgcn_mfma_f32_32x32x16_bf16(kf[6],qr[3],C0,0,0,0),   P1[10],P1[11],P1[12],P1[13], pw3[0]=PKW(P1,8), pw3[1]=PKW(P1,10), pw3); \
    VRD(7); SBAR(); GAPA(C1=__builtin_amdgcn_mfma_f32_32x32x16_bf16(kf[7],qr[3],C1,0,0,0),   P1[14],P1[15],0.f,0.f,       pw3[2]=PKW(P1,12),pw3[3]=PKW(P1,14), pw3); \
    l_reg+=sacc; \
    if(GK){DMA_K((t)+3,sl_cur);} if(GV){DMA_V((t)+1,sl_next);} \
    CMASK(C0,C1,t); \
    { float a=MX3(C0[0],C0[1],C1[0]),b=MX3(C0[2],C0[3],C1[1]); a=MX3(a,C1[2],C1[3]); \
      _Pragma("unroll") for(int r=4;r<16;r+=4){a=MX3(a,C0[r],C0[r+1]);b=MX3(b,C0[r+2],C0[r+3]);a=MX3(a,C1[r],C1[r+1]);b=MX3(b,C1[r+2],C1[r+3]);} \
      float rm=__builtin_fmaxf(a,b); { auto rr=__builtin_amdgcn_permlane32_swap(__float_as_uint(rm),__float_as_uint(rm),false,false); rm=__builtin_fmaxf(__uint_as_float(rr[0]),__uint_as_float(rr[1])); } \
      resc=false; \
      if(__builtin_expect(__any(rm>(float)THRL),0)){ const float dl=__builtin_fmaxf(rm,0.f); mhat+=dl; \
        _Pragma("unroll") for(int r=0;r<16;++r){C0[r]-=dl;C1[r]-=dl;} \
        if constexpr(!MOBA){ _Pragma("unroll") for(int r=0;r<16;++r)negm[r]=-mhat; asm volatile("":"+v"(negm)); } \
        const float f=__builtin_amdgcn_exp2f(-dl); l_reg*=f; if(hi==0)wsf[r32]=f; resc=true; } } \
    SBAR(); \
    GAPB(o[0]=__builtin_amdgcn_mfma_f32_32x32x16_bf16(PAF(0),VFR(0),o[0],0,0,0), C0,0); \
    GAPB(o[1]=__builtin_amdgcn_mfma_f32_32x32x16_bf16(PAF(0),VFR(4),o[1],0,0,0), C0,4); \
    KRD(GL,0); GAPB(o[0]=__builtin_amdgcn_mfma_f32_32x32x16_bf16(PAF(1),VFR(1),o[0],0,0,0), C0,8); \
    KRD(GL,1); GAPB(o[1]=__builtin_amdgcn_mfma_f32_32x32x16_bf16(PAF(1),VFR(5),o[1],0,0,0), C0,12); \
    KRD(GL,2); GAPB(o[0]=__builtin_amdgcn_mfma_f32_32x32x16_bf16(PAF(2),VFR(2),o[0],0,0,0), C1,0); \
    KRD(GL,3); GAPB(o[1]=__builtin_amdgcn_mfma_f32_32x32x16_bf16(PAF(2),VFR(6),o[1],0,0,0), C1,4); \
    GAPB(o[0]=__builtin_amdgcn_mfma_f32_32x32x16_bf16(PAF(3),VFR(3),o[0],0,0,0), C1,8); \
    GAPB(o[1]=__builtin_amdgcn_mfma_f32_32x32x16_bf16(PAF(3),VFR(7),o[1],0,0,0), C1,12); \
    }while(0)
  int t=1;
  #undef CMASK
  #define CMASK(P0,P1,t) MBIAS(P0,P1,t,false)
  for(;t+5<NT;t+=2){
    STEP(pB0,pB1,pA0,pA1,t,true,true,true);     WAIT_BAR(2); RESC(); ROT();
    STEP(pA0,pA1,pB0,pB1,t+1,true,true,true);   WAIT_BAR(2); RESC(); ROT();
  }
  #undef CMASK
  #define CMASK(P0,P1,t) do{int jb_=(t)-(NT-4); MBIAS(P0,P1,t,jb_>=0); if(jb_>=0)cmask(P0,P1,jb_,qrel,hi);}while(0)
  #define ENDW(tt) do{ if((tt)+3<NT){WAIT_BAR(2);} else if((tt)+2<NT){WAIT_BAR(1);} else {WAIT_BAR(0);} }while(0)
  for(;t+1<NT;t+=2){
    STEP(pB0,pB1,pA0,pA1,t,(t+3<NT),(t+1<NT),(t+1<NT));       ENDW(t);   RESC(); ROT();
    STEP(pA0,pA1,pB0,pB1,t+1,(t+4<NT),(t+2<NT),(t+2<NT));     ENDW(t+1); RESC(); ROT();
  }
  STEP(pB0,pB1,pA0,pA1,NT-1,false,false,false); RESC();
  { float sacc=pB0[0]+pB0[1]; _Pragma("unroll") for(int r=2;r<16;++r)sacc+=pB0[r]; _Pragma("unroll") for(int r=0;r<16;++r)sacc+=pB1[r]; l_reg+=sacc;
    pw0=(u32x4){PKW(pB0,0),PKW(pB0,2),PKW(pB0,4),PKW(pB0,6)};pw1=(u32x4){PKW(pB0,8),PKW(pB0,10),PKW(pB0,12),PKW(pB0,14)};pw2=(u32x4){PKW(pB1,0),PKW(pB1,2),PKW(pB1,4),PKW(pB1,6)};pw3=(u32x4){PKW(pB1,8),PKW(pB1,10),PKW(pB1,12),PKW(pB1,14)};
    SBAR(); pv(o,vb0+sl_cur,PAF(0),PAF(1),PAF(2),PAF(3)); }
  #undef PKW
  #undef PAF
  #undef VFR
  #undef PIN
  #undef MX3
  #undef GAPA
  #undef GAPB
  #undef EX
  #undef VRD
  #undef KRD
  #undef STEP
  #undef ENDW
  {auto rr=__builtin_amdgcn_permlane32_swap(__float_as_uint(l_reg),__float_as_uint(l_reg),false,false);l_reg=__uint_as_float(rr[0])+__uint_as_float(rr[1]);}
  if(hi==0)wsf[32+r32]=l_reg;asm volatile("s_waitcnt lgkmcnt(0)":::"memory");
  float rli[16];
  #pragma unroll
  for(int r=0;r<16;++r)rli[r]=__builtin_amdgcn_rcpf(wsf[32+crow(r,hi)]);
  bf16*Ow=O+(rowbase+q0+wid*QBLK)*DMO+hv*D;
  { bf16*stg=(bf16*)(shm+LDS_OST)+wid*2048;
    #pragma unroll
    for(int r=0;r<16;++r){const int orow=crow(r,hi);
      #pragma unroll
      for(int d0=0;d0<2;++d0)stg[orow*64+d0*32+r32]=__float2bfloat16(o[d0][r]*rli[r]);}
    asm volatile("s_waitcnt lgkmcnt(0)":::"memory");
    #pragma unroll
    for(int i=0;i<4;++i){const int row=i*8+(lane>>3),ch=lane&7; const u32x4 v=*(const u32x4*)(stg+row*64+ch*8); ATTN_STORE16(Ow+(long)row*DMO+ch*8,v);} }
  asm volatile("s_waitcnt lgkmcnt(0)\n\ts_barrier":::"memory");
  #undef DMA_K
  #undef DMA_V
  #undef CMASK
  #undef START
  #undef RESC
  #undef ROT
  #undef MBIAS
}
__device__ __forceinline__ void glds16s(const void*sbase,unsigned voff,unsigned lds_dst){unsigned keep;
  asm volatile("s_mov_b32 %0, m0\n\ts_mov_b32 m0, %3\n\ts_nop 0\n\tglobal_load_lds_dwordx4 %1, %2\n\ts_mov_b32 m0, %0":"=&s"(keep):"v"(voff),"s"(sbase),"s"(lds_dst):"memory");}
constexpr int L2_K=0, L2_V=4*8192, L2_WS=L2_V+4*16384, L2_OST=L2_WS+2048, L2_BYTES=L2_OST+NW*4096;
template<int THRL,int DM,int EXPM=0> __device__ __forceinline__ void attn_unit2(int b,int hq,int hv,int qb,const bf16*Q,const bf16*__restrict__ K,const bf16*__restrict__ V,bf16*O,char*shm,int combine,const float*sg,const float*lamp,float oscale,int desc,const int wv_){
  int tid=(mk_lane()+((wv_)<<6)); asm volatile("":"+v"(tid));
  const int lane=tid&63,r32=lane&31,hi=lane>>5; const int wid=__builtin_amdgcn_readfirstlane(tid>>6);
  const long rowbase=(long)b*SEQ; const int q0=qb*QB;
  const bf16*Qw=Q+(rowbase+q0+wid*QBLK)*DM+hq*D;
  const bf16*Kh=K+rowbase*DM+hq*D,*Vh=V+rowbase*DM+hv*128;
  const unsigned lds0=(unsigned)(uintptr_t)shm;
  float*wsf=(float*)(shm+L2_WS)+wid*64;
  const bf16*ksb=Kh+wid*8; const unsigned kvo=(unsigned)lane*DM*2u;
  const bf16*vsb=Vh+(long)(16*(wid&3))*DM+(wid>>2)*32; const unsigned vvo=((unsigned)(lane>>2)*DM+(lane&3)*8)*2u;
  const unsigned kdst=lds0+L2_K+wid*1024, vdst=lds0+L2_V+wid*1024;
  #define DMAK(t,soff) if constexpr(!(EXPM&4)) glds16s(ksb+(long)(t)*KVBLK*DM,kvo,(unsigned)__builtin_amdgcn_readfirstlane(kdst+(soff)))
  #define DMAV(t,soff) do{ if constexpr(!(EXPM&4)){ glds16s(vsb+(long)(t)*KVBLK*DM,vvo,(unsigned)__builtin_amdgcn_readfirstlane(vdst+(soff))); } if constexpr(!(EXPM&4)) glds16s(vsb+(long)(t)*KVBLK*DM+64,vvo,(unsigned)__builtin_amdgcn_readfirstlane(vdst+(soff)+8192)); }while(0)
  const lds_cptr shm3=(lds_cptr)shm; const lds_cptr kp0=shm3+L2_K+hi*1024+r32*16; const lds_cptr vp0=shm3+L2_V+((lane>>4)&1)*32+(lane&3)*8+(4*hi+((lane&15)>>2))*64;
  const int NT=(q0+QB)/KVBLK;
  #define TI(j) (desc?NT-1-(j):(j))
  if(wid>=4) __builtin_amdgcn_s_setprio(1);
  DMAK(TI(0),0); DMAV(TI(0),0); DMAK(TI(1),8192); DMAV(TI(1),16384); DMAK(TI(2),16384);
  bf16x8 qr[4];
  #pragma unroll
  for(int d0=0;d0<4;++d0)qr[d0]=*reinterpret_cast<const bf16x8*>(&Qw[(long)r32*DM+d0*16+hi*8]);
  asm volatile(""::"v"(qr[0]),"v"(qr[1]),"v"(qr[2]),"v"(qr[3]));
  float mhat=0.f,l_reg=0.f; f32x16 o[4]; o[0]=f32x16{};o[1]=f32x16{};o[2]=f32x16{};o[3]=f32x16{};
  const f32x16 zero=f32x16{};
  bool resc=false;
  #define EX2(v) __builtin_amdgcn_exp2f(v)
  #define PIN2(x) asm volatile("":"+v"(x))
  #define MX3(a,b,c) __builtin_fmaxf(__builtin_fmaxf((a),(b)),(c))
  #define ROWMAX_FIN(a_,b_) do{ rm=__builtin_fmaxf(a_,b_); auto rr_=__builtin_amdgcn_permlane32_swap(__float_as_uint(rm),__float_as_uint(rm),false,false); rm=__builtin_fmaxf(__uint_as_float(rr_[0]),__uint_as_float(rr_[1])); }while(0)
  f32x16 pA0,pA1,pB0,pB1; float rm;
  WAIT_BAR(6);
  qkt(pA0,pA1,shm+L2_K,qr,zero,r32,hi);
  { const int jb0_=TI(0)-(NT-4); if(jb0_>=0) cmask(pA0,pA1,jb0_,wid*QBLK+r32,hi); }
  { float a_=MX3(pA0[0],pA0[1],pA1[0]),b_=MX3(pA0[2],pA0[3],pA1[1]); a_=MX3(a_,pA1[2],pA1[3]);
    #pragma unroll
    for(int r=4;r<16;r+=4){a_=MX3(a_,pA0[r],pA0[r+1]);b_=MX3(b_,pA0[r+2],pA0[r+3]);a_=MX3(a_,pA1[r],pA1[r+1]);b_=MX3(b_,pA1[r+2],pA1[r+3]);}
    ROWMAX_FIN(a_,b_); mhat=__builtin_fmaxf(rm,-64.f);
    #pragma unroll
    for(int r=0;r<16;++r){pA0[r]-=mhat;pA1[r]-=mhat;} }
  f32x16 negm;
  #pragma unroll
  for(int r=0;r<16;++r)negm[r]=-mhat;
  asm volatile("":"+v"(negm));
  const bool grpB=false;
  #define TOPBLK(tt) do{ if constexpr(!(EXPM&8)){ if((tt)+2<NT){ WAIT_BAR(3); } else if((tt)+1<NT){ WAIT_BAR(2); } else { WAIT_BAR(0); } } \
    if((tt)+2<NT){ DMAV(TI((tt)+2),(((tt)+2)&3)*16384); } if((tt)+3<NT){ DMAK(TI((tt)+3),(((tt)+3)&3)*8192); } }while(0)
  if(grpB) TOPBLK(0);
  #define EXP4(P,B) do{ if constexpr(!(EXPM&1)){ P[B]=EX2(P[B]); P[B+1]=EX2(P[B+1]); P[B+2]=EX2(P[B+2]); P[B+3]=EX2(P[B+3]); } }while(0)
  #define KL(i) if constexpr(!(EXPM&16)) kf[(i)&3]=*(const __attribute__((address_space(3))) bf16x8*)(kp0+kn+((i)>>1)*2048+((i)&1)*512)
  #define VOFFL(i) (((i)&1)*4096+((i)>>1)*1024)
  #define VRDL(i) do{ if constexpr(!(EXPM&16)){ vl[i]=vtr(vp_+VOFFL(i)); vh[i]=vtr(vp_+VOFFL(i)+512); } }while(0)
  #define VRDH(i) do{ if constexpr(!(EXPM&18)){ vl[i]=vtr(vp_+8192+VOFFL(i)); vh[i]=vtr(vp_+8192+VOFFL(i)+512); } }while(0)
  #define VFR2(i) (bf16x8){vl[i][0],vl[i][1],vl[i][2],vl[i][3],vh[i][0],vh[i][1],vh[i][2],vh[i][3]}
  #define PAF2(k) __builtin_bit_cast(bf16x8,pw[k])
  #define PKW2(P,B) cvtpk_s(P[B],P[B+1])
  #define G1(i,PNX,CIN,PC,PCB) do{ PNX=__builtin_amdgcn_mfma_f32_32x32x16_bf16(kf[(i)&3],qr[(i)>>1],CIN,0,0,0); if((i)<4){KL((i)+4);} VRDL(i); if((PCB)>=0){ EXP4(PC,((PCB)>=0?(PCB):0)); PIN2(PC); } SBAR(); }while(0)
  #define G2A(j,PC,PCB,HN,PN,PNB) do{ const bf16x8 vf_=VFR2(j); VRDH(j); o[(j)&1]=__builtin_amdgcn_mfma_f32_32x32x16_bf16(PAF2((j)>>1),vf_,o[(j)&1],0,0,0); \
      sacc+=PC[PCB]; sacc+=PC[PCB+1]; sacc+=PC[PCB+2]; sacc+=PC[PCB+3]; PIN2(sacc); \
      if(HN){ ma=MX3(ma,PN[PNB],PN[PNB+1]); ma=MX3(ma,PN[PNB+2],PN[PNB+3]); PIN2(ma); } SBAR(); }while(0)
  #define G2B(j) do{ if constexpr(!(EXPM&2)){ const bf16x8 vf_=VFR2(j); o[2+((j)&1)]=__builtin_amdgcn_mfma_f32_32x32x16_bf16(PAF2((j)>>1),vf_,o[2+((j)&1)],0,0,0); SBAR(); } }while(0)
  #define STEP2(PC0,PC1,PN0,PN1,t,HN) do{ \
    if(!grpB){ TOPBLK(t); }                         \
    const int kn=(((t)+1)&3)*8192, vc=((t)&3)*16384; \
    if(resc){ const float*wp_=(const float*)(shm+L2_WS)+wid*64+4*(mk_lane()>>5); _Pragma("unroll") for(int r=0;r<16;++r){ const float f_=wp_[(r&3)+8*(r>>2)]; o[0][r]*=f_; o[1][r]*=f_; o[2][r]*=f_; o[3][r]*=f_; } } \
    bf16x8 kf[4]; const lds_cptr vp_=vp0+vc; s16x4 vl[8],vh[8]; \
    if(HN){ KL(0); KL(1); KL(2); KL(3); } \
    SBAR(); \
    if(HN){ \
      EXP4(PC0,0); EXP4(PC0,4); PIN2(PC0); SBAR();                    \
      G1(0,PN0,negm,PC0,8); G1(1,PN1,negm,PC0,12); G1(2,PN0,PN0,PC1,0); G1(3,PN1,PN1,PC1,4); \
      G1(4,PN0,PN0,PC1,8);  G1(5,PN1,PN1,PC1,12);  G1(6,PN0,PN0,PC1,-1); G1(7,PN1,PN1,PC1,-1); \
    } else { VRDL(0); VRDL(1); VRDL(2); VRDL(3); VRDL(4); VRDL(5); VRDL(6); VRDL(7); \
      EXP4(PC0,0); EXP4(PC0,4); EXP4(PC0,8); EXP4(PC0,12); EXP4(PC1,0); EXP4(PC1,4); EXP4(PC1,8); EXP4(PC1,12); } \
    u32x4 pw[4]; pw[0]=(u32x4){PKW2(PC0,0),PKW2(PC0,2),PKW2(PC0,4),PKW2(PC0,6)}; pw[1]=(u32x4){PKW2(PC0,8),PKW2(PC0,10),PKW2(PC0,12),PKW2(PC0,14)}; \
    pw[2]=(u32x4){PKW2(PC1,0),PKW2(PC1,2),PKW2(PC1,4),PKW2(PC1,6)}; pw[3]=(u32x4){PKW2(PC1,8),PKW2(PC1,10),PKW2(PC1,12),PKW2(PC1,14)}; \
    if(HN){ const int jb_=TI((t)+1)-(NT-4); if(jb_>=0){ const int ln_=mk_lane(); cmask(PN0,PN1,jb_,wid*QBLK+(ln_&31),ln_>>5); } } \
    if(grpB){ if((t)+1<NT){ TOPBLK((t)+1); } else { if constexpr(!(EXPM&8)){ WAIT_BAR(0); } } } \
    float sacc=0.f,ma=-INFINITY; SBAR(); \
    G2A(0,PC0,0,HN,PN0,0);  G2A(1,PC0,4,HN,PN0,4);  G2A(2,PC0,8,HN,PN0,8);   G2A(3,PC0,12,HN,PN0,12); \
    G2A(4,PC1,0,HN,PN1,0);  G2A(5,PC1,4,HN,PN1,4);  G2A(6,PC1,8,HN,PN1,8);   G2A(7,PC1,12,HN,PN1,12); \
    G2B(0); G2B(1); G2B(2); G2B(3); G2B(4); G2B(5); G2B(6); G2B(7); \
    l_reg+=sacc; resc=false; \
    if(HN){ ROWMAX_FIN(ma,ma); \
      if(__any(rm>(float)THRL)){ const float dl_=__builtin_fmaxf(rm,0.f); mhat+=dl_; _Pragma("unroll") for(int r=0;r<16;++r){PN0[r]-=dl_;PN1[r]-=dl_;} _Pragma("unroll") for(int r=0;r<16;++r)negm[r]=-mhat; asm volatile("":"+v"(negm)); \
        const float f_=EX2(-dl_); l_reg*=f_; { const int ln_=mk_lane(); if(ln_<32)((float*)(shm+L2_WS))[wid*64+ln_]=f_; } resc=true; } } \
  }while(0)
  int t=0;
  #pragma unroll 1
  for(;t+2<NT;t+=2){
    STEP2(pA0,pA1,pB0,pB1,t,true);
    STEP2(pB0,pB1,pA0,pA1,t+1,true);
  }
  STEP2(pA0,pA1,pB0,pB1,NT-2,true);
  STEP2(pB0,pB1,pA0,pA1,NT-1,false);
  if(!grpB){ if constexpr(!(EXPM&8)){ WAIT_BAR(0); } }
  #undef STEP2
  #undef TI
  #undef TOPBLK
  #undef G1
  #undef G2A
  #undef G2B
  #undef KL
  #undef VRDL
  #undef VRDH
  #undef VOFFL
  #undef PKW2
  #undef PAF2
  #undef VFR2
  #undef EXP4
  #undef ROWMAX_FIN
  #undef MX3
  #undef EX2
  #undef PIN2
  #undef DMAK
  #undef DMAV
  __builtin_amdgcn_s_setprio(0);
  {
    int tid2=(mk_lane()+((wv_)<<6)); asm volatile("":"+v"(tid2));
    const int lane_e=tid2&63,r32e=lane_e&31,hie=lane_e>>5;
    float*wsfe=(float*)(shm+L2_WS)+wid*64;
    {auto rr=__builtin_amdgcn_permlane32_swap(__float_as_uint(l_reg),__float_as_uint(l_reg),false,false);l_reg=__uint_as_float(rr[0])+__uint_as_float(rr[1]);}
    if(hie==0)wsfe[32+r32e]=l_reg;asm volatile("s_waitcnt lgkmcnt(0)":::"memory");
    float rli[16];
    #pragma unroll
    for(int r=0;r<16;++r)rli[r]=__builtin_amdgcn_rcpf(wsfe[32+crow(r,hie)]);
    bf16*Ow=O+((long)b*SEQ+qb*QB+wid*QBLK)*DM+hv*128;
    bf16*stg=(bf16*)(shm+L2_OST)+wid*2048;
    if(!combine){
      #pragma unroll
      for(int hf=0;hf<2;++hf){
        #pragma unroll
        for(int r=0;r<16;++r){const int orow=crow(r,hie);
          #pragma unroll
          for(int d0=0;d0<2;++d0)stg[orow*64+d0*32+r32e]=__float2bfloat16(o[2*hf+d0][r]*rli[r]);}
        asm volatile("s_waitcnt lgkmcnt(0)":::"memory");
        #pragma unroll
        for(int i=0;i<4;++i){const int row=i*8+(lane_e>>3),ch=lane_e&7; const u32x4 v=*(const u32x4*)(stg+row*64+ch*8); ATTN_STORE16(Ow+(long)row*DM+hf*64+ch*8,v);}
        asm volatile("s_waitcnt lgkmcnt(0)":::"memory"); }
    } else {
      const float lam2=*lamp; const float osc2=oscale;
      u32x4 o0c[2][4];
      #pragma unroll
      for(int hf=0;hf<2;++hf)
        #pragma unroll
        for(int i=0;i<4;++i) o0c[hf][i]=*(const u32x4*)(Ow+(long)(i*8+(lane_e>>3))*DM+hf*64+(lane_e&7)*8);
      float dd[2][4][8]; float ssq[4]={0.f,0.f,0.f,0.f};
      #pragma unroll
      for(int hf=0;hf<2;++hf){
        #pragma unroll
        for(int r=0;r<16;++r){const int orow=crow(r,hie);
          #pragma unroll
          for(int d0=0;d0<2;++d0)stg[orow*64+d0*32+r32e]=__float2bfloat16(o[2*hf+d0][r]*rli[r]);}
        asm volatile("s_waitcnt lgkmcnt(0)":::"memory");
        #pragma unroll
        for(int i=0;i<4;++i){const int row=i*8+(lane_e>>3),ch=lane_e&7; const u32x4 v=*(const u32x4*)(stg+row*64+ch*8);
          #pragma unroll
          for(int e=0;e<4;++e){ const float a0=__uint_as_float(o0c[hf][i][e]<<16),a1=__uint_as_float(o0c[hf][i][e]&0xffff0000u),b0=__uint_as_float(v[e]<<16),b1=__uint_as_float(v[e]&0xffff0000u);
            const float x0=a0-lam2*b0,x1=a1-lam2*b1; dd[hf][i][2*e]=x0; dd[hf][i][2*e+1]=x1; ssq[i]+=x0*x0+x1*x1; } }
        asm volatile("s_waitcnt lgkmcnt(0)":::"memory"); }
      #pragma unroll
      for(int i=0;i<4;++i){ float q=ssq[i];
        q+=__uint_as_float(__builtin_amdgcn_update_dpp(0u,__float_as_uint(q),0xB1,0xF,0xF,true)); q+=__uint_as_float(__builtin_amdgcn_update_dpp(0u,__float_as_uint(q),0x4E,0xF,0xF,true)); q+=__uint_as_float(__builtin_amdgcn_update_dpp(0u,__float_as_uint(q),0x141,0xF,0xF,true));
        ssq[i]=osc2*__builtin_amdgcn_rsqf(q*(1.0f/128.0f)+1e-6f); }
      #pragma unroll
      for(int hf=0;hf<2;++hf){ const float*gp=sg+hf*64+(lane_e&7)*8; const f32x4m g0=*reinterpret_cast<const f32x4m*>(gp), g1=*reinterpret_cast<const f32x4m*>(gp+4);
        #pragma unroll
        for(int i=0;i<4;++i){ const int row=i*8+(lane_e>>3),ch=lane_e&7; const float rr_=ssq[i]; u32x4 w;
          w[0]=cvtpk_s(dd[hf][i][0]*rr_*g0[0],dd[hf][i][1]*rr_*g0[1]); w[1]=cvtpk_s(dd[hf][i][2]*rr_*g0[2],dd[hf][i][3]*rr_*g0[3]);
          w[2]=cvtpk_s(dd[hf][i][4]*rr_*g1[0],dd[hf][i][5]*rr_*g1[1]); w[3]=cvtpk_s(dd[hf][i][6]*rr_*g1[2],dd[hf][i][7]*rr_*g1[3]);
          ATTN_STORE16(Ow+(long)row*DM+hf*64+ch*8,w); } }
    } }
}

#undef SBAR
#undef WAIT_BAR
}


namespace cg = cooperative_groups;
#define LAS __attribute__((address_space(3)))
typedef unsigned short u16;
typedef unsigned v4u __attribute__((ext_vector_type(4)));
typedef unsigned v2u __attribute__((ext_vector_type(2)));
typedef float f32x4 __attribute__((ext_vector_type(4)));
typedef float f32x16 __attribute__((ext_vector_type(16)));
typedef short bf16x8 __attribute__((ext_vector_type(8)));

#define RLX_AGENT __ATOMIC_RELAXED, __HIP_MEMORY_SCOPE_AGENT
#define XB_TMO      128
#define XB_XCNT(j)  (256  + 64 * (j))
#define XB_XSUB(j)  (1280 + 64 * (j))
#define XB_XGEN(j)  (2304 + 64 * (j))
#define XB_TOP      3328
#define XB_TOPGEN   3392
#define XCD_BAR_WORDS 3456
#define XB_SPIN_CAP (1u << 18)

__device__ __forceinline__ unsigned xb_ld(unsigned* p)              { return __hip_atomic_load(p, __ATOMIC_RELAXED, __HIP_MEMORY_SCOPE_AGENT); }
__device__ __forceinline__ unsigned xb_add(unsigned* p, unsigned v) { return __hip_atomic_fetch_add(p, v, __ATOMIC_RELAXED, __HIP_MEMORY_SCOPE_AGENT); }
__device__ __forceinline__ unsigned xb_xcc_id() { return (unsigned)__builtin_amdgcn_s_getreg((3 << 11) | 20) & 0xFu; }
#define XB_SPIN(cond, bar) do { unsigned _sp = 0; while (cond) { __builtin_amdgcn_s_sleep(1); \
    if ((++_sp & 255u) == 0u) { if (xb_ld(&(bar)[XB_TMO])) break; if (_sp > XB_SPIN_CAP) { atomicAdd(&(bar)[XB_TMO], 1u); break; } } } } while (0)

struct XcdBarrier {
    unsigned* bar; unsigned x;
    volatile LAS unsigned* st;
};

__device__ __forceinline__ XcdBarrier xcd_barrier_post(unsigned* bar, volatile LAS unsigned* st, const int wv_) {
    XcdBarrier b; b.bar = bar; b.x = xb_xcc_id(); b.st = st;
    if ((mk_lane()+((wv_)<<6)) == 0) (void)xb_add(&bar[XB_XCNT(b.x)], 1u);
    return b;
}
__device__ __forceinline__ void xcd_barrier_complete(unsigned* bar, unsigned x, unsigned& nloc, unsigned& nx) {
    const unsigned G = gridDim.x * gridDim.y * gridDim.z;
    unsigned sum, cnt, mine, sp = 0u;
    for (;;) {
        sum = 0u; cnt = 0u; mine = 0u;
#pragma unroll
        for (unsigned j = 0; j < 16; ++j) { const unsigned c = xb_ld(&bar[XB_XCNT(j)]); sum += c; cnt += (c > 0u) ? 1u : 0u; mine = (j == x) ? c : mine; }
        if (sum == G) break;
        __builtin_amdgcn_s_sleep(1);
        if ((++sp & 255u) == 0u) { if (xb_ld(&bar[XB_TMO])) break; if (sp > XB_SPIN_CAP) { atomicAdd(&bar[XB_TMO], 1u); break; } }
    }
    nloc = mine > 0u ? mine : 1u; nx = cnt > 0u ? cnt : 1u;
}

__device__ __forceinline__ void xcd_barrier(const XcdBarrier& b, const int wv_) {
    asm volatile("s_waitcnt vmcnt(0)" ::: "memory");
    __syncthreads();
    if ((mk_lane()+((wv_)<<6)) == 0) {
        unsigned* bar = b.bar;
        __builtin_amdgcn_s_waitcnt(0);
        unsigned nloc = b.st[0], nx = b.st[1];
        if (nloc == 0u) { xcd_barrier_complete(bar, b.x, nloc, nx); b.st[0] = nloc; b.st[1] = nx; }
        const unsigned old = xb_add(&bar[XB_XSUB(b.x)], 1u);
        const unsigned gen = old / nloc;
        if (old + 1u == (gen + 1u) * nloc) {
            __builtin_amdgcn_fence(__ATOMIC_RELEASE, "agent");
            asm volatile("s_waitcnt vmcnt(0)" ::: "memory");
            const unsigned og = xb_add(&bar[XB_TOP], 1u);
            const unsigned tg = og / nx;
            if (og + 1u == (tg + 1u) * nx) xb_add(&bar[XB_TOPGEN], 1u);
            else XB_SPIN(xb_ld(&bar[XB_TOPGEN]) == tg, bar);
            __builtin_amdgcn_fence(__ATOMIC_ACQUIRE, "agent");
            xb_add(&bar[XB_XGEN(b.x)], 1u);
            asm volatile("s_waitcnt vmcnt(0)" ::: "memory");
        } else {
            XB_SPIN(xb_ld(&bar[XB_XGEN(b.x)]) == gen, bar);
            __builtin_amdgcn_fence(__ATOMIC_ACQUIRE, "agent");
            asm volatile("s_waitcnt vmcnt(0)" ::: "memory");
        }
    }
    __syncthreads();
}

constexpr int NWAVES = 8;
constexpr int BATCH = 4, SEQ = 8192, DMODEL = 1024, FF = 2816, M = BATCH * SEQ;
constexpr int LDS_BYTES = 147456;
constexpr size_t MiB = 1u << 20;
constexpr size_t WS_ROPE = 0;
constexpr size_t WS_KMEAN = 1 * MiB;
constexpr size_t WS_SS = 2 * MiB;
constexpr size_t WS_LAM = 6 * MiB;
constexpr size_t WS_BAR = 5 * MiB;
constexpr size_t WS_RDY = 5 * MiB + 64 * 1024;
constexpr unsigned BAR_MAGIC = 0x5eed1234u;
constexpr size_t WS_WSB = 4 * MiB;
constexpr size_t WS_W = 8 * MiB;
constexpr size_t WS_XB = 96 * MiB;
constexpr size_t WS_H = 160 * MiB;
constexpr size_t WS_EQ = 160 * MiB;
constexpr size_t WS_EY = 336 * MiB;
constexpr size_t WS_OQ = 160 * MiB;
constexpr size_t WS_O0 = 352 * MiB, WS_O1 = 416 * MiB;
constexpr size_t WS_END = 480 * MiB;
constexpr size_t W_GU = 0, W_GU_SZ = (size_t)2 * FF * DMODEL, W_DN = 4 * W_GU_SZ, W_DN_SZ = (size_t)FF * DMODEL;
constexpr size_t W_EIN = W_DN + 4 * W_DN_SZ, W_EOUT = W_EIN + (size_t)2560 * 1024, W_OIN = W_EOUT + (size_t)1024 * 1024, W_OOUT = W_OIN + (size_t)3072 * 1024, W_ENDE = W_OOUT + (size_t)1024 * 1024;
static_assert(WS_W + W_ENDE * 2 <= WS_XB, "weights fit");
constexpr float C2Q = 0.125f * 1.4426950408889634f;

__device__ __forceinline__ float wave_sum(float v) {
#pragma unroll
    for (int o = 1; o < 64; o <<= 1) v += __shfl_xor(v, o);
    return v;
}
__device__ __forceinline__ unsigned f2bf(float f) { unsigned u = __builtin_bit_cast(unsigned, f); return (u + 0x7fffu + ((u >> 16) & 1u)) >> 16; }
__device__ __forceinline__ unsigned pk2(float lo, float hi) { return f2bf(lo) | (f2bf(hi) << 16); }
__device__ __forceinline__ float bf2f(unsigned h) { return __builtin_bit_cast(float, h << 16); }
__device__ __forceinline__ int dimof(int p) { return p < 16 ? ((p & 1) ? (p >> 1) + 8 : (p >> 1)) : p; }

__device__ __forceinline__ int physof(int d) { return d < 8 ? 2 * d : (d < 16 ? 2 * (d - 8) + 1 : d); }
__device__ __forceinline__ void tr_item(const float* W, int K, int Nsrc, int scol0, bool perm, const float* gain, u16* WT, int n0dst, int k0, LAS float* scr, int lane) {
    const int rr = lane >> 3, c4 = (lane & 7) * 4;
    f32x4 w[8];
#pragma unroll
    for (int i = 0; i < 8; ++i) w[i] = *(const f32x4*)(W + (size_t)(k0 + 8 * i + rr) * Nsrc + scol0 + c4);
    int dp[4];
#pragma unroll
    for (int j = 0; j < 4; ++j) dp[j] = perm ? physof(c4 + j) : (c4 + j);
#pragma unroll
    for (int i = 0; i < 8; ++i) { const int kk = 8 * i + rr; const float g = gain ? gain[k0 + kk] : 1.0f;
#pragma unroll
        for (int j = 0; j < 4; ++j) scr[kk * 33 + dp[j]] = w[i][j] * g; }
    asm volatile("s_waitcnt lgkmcnt(0)" ::: "memory");
    const int c = lane & 7;
#pragma unroll
    for (int j = 0; j < 4; ++j) { const int n = (lane >> 3) + 8 * j; const LAS float* s = scr + (8 * c) * 33 + n;
        v4u o; o.x = pk2(s[0 * 33], s[1 * 33]); o.y = pk2(s[2 * 33], s[3 * 33]); o.z = pk2(s[4 * 33], s[5 * 33]); o.w = pk2(s[6 * 33], s[7 * 33]);
        *(v4u*)(WT + (size_t)(n0dst + n) * K + k0 + 8 * c) = o; }
    asm volatile("s_waitcnt lgkmcnt(0)" ::: "memory");
}

#ifndef PHASES
#define PHASES 0xff
#endif
#define PHON(k) (((PHASES) >> (k)) & 1)
#ifndef NOATT
#define NOATT 0
#endif
#ifndef NOGMLP
#define NOGMLP 0
#endif
struct Args { const float* in[24]; float* out; unsigned char* ws; };

__device__ __forceinline__ void gmlp_unit(int chunk, int g, int lane, LAS unsigned char* wl, const u16* U, const u16* Vg, const float* lng, const float* lnb, const u16* Wsb, const float* bs, u16* Y) {
    const int row0 = chunk * 128, r32 = lane & 31, hi = lane >> 5;
    LAS u16* vT = (LAS u16*)wl;
#pragma unroll 1
    for (int rr = 0; rr < 2; ++rr) { const int s = lane + 64 * rr; const v4u* vp = (const v4u*)(Vg + (size_t)(row0 + s) * 512 + g * 64);
        float v[64];
#pragma unroll
        for (int c = 0; c < 8; ++c) { const v4u w = vp[c];
#pragma unroll
            for (int e = 0; e < 4; ++e) { v[c * 8 + 2 * e] = bf2f(w[e] & 0xffffu); v[c * 8 + 2 * e + 1] = bf2f(w[e] >> 16); } }
        float sum = 0.f;
#pragma unroll
        for (int d = 0; d < 64; ++d) sum += v[d];
        const float mean = sum * (1.0f / 64.0f); float var = 0.f;
#pragma unroll
        for (int d = 0; d < 64; ++d) { v[d] -= mean; var += v[d] * v[d]; }
        const float rstd = 1.0f / sqrtf(var * (1.0f / 64.0f) + 1e-6f);
#pragma unroll
        for (int d = 0; d < 64; ++d) { const float y = v[d] * rstd * lng[g * 64 + d] + lnb[g * 64 + d]; vT[d * 136 + s] = (u16)f2bf(y); }
    }
    asm volatile("s_waitcnt lgkmcnt(0)" ::: "memory");
    const u16* Wg = Wsb + (size_t)g * 16384;
    f32x16 acc[4][2];
#pragma unroll
    for (int ti = 0; ti < 4; ++ti)
#pragma unroll
        for (int di = 0; di < 2; ++di) { acc[ti][di] = f32x16{};
#pragma unroll
            for (int ks = 0; ks < 2 * ti + 2; ++ks) { const bf16x8 a = *(const bf16x8*)(Wg + (size_t)(32 * ti + r32) * 128 + 16 * ks + 8 * hi);
                const bf16x8 b = *(const LAS bf16x8*)(vT + (32 * di + r32) * 136 + 16 * ks + 8 * hi);
                acc[ti][di] = __builtin_amdgcn_mfma_f32_32x32x16_bf16(a, b, acc[ti][di], 0, 0, 0); }
            __builtin_amdgcn_sched_barrier(0); }
    asm volatile("s_waitcnt lgkmcnt(0)" ::: "memory");
    LAS u16* mx = (LAS u16*)wl;
    LAS u16* mb = mx + (4 * hi) * 64 + r32;
#pragma unroll
    for (int ti = 0; ti < 4; ++ti)
#pragma unroll
        for (int di = 0; di < 2; ++di)
#pragma unroll
            for (int r = 0; r < 16; ++r) mb[(32 * ti + (r & 3) + 8 * (r >> 2)) * 64 + 32 * di] = (u16)f2bf(acc[ti][di][r]);
    v4u uc[16];
#pragma unroll
    for (int i = 0; i < 16; ++i) { const int id = i * 64 + lane; uc[i] = *(const v4u*)(U + (size_t)(row0 + (id >> 3)) * 512 + g * 64 + (id & 7) * 8); }
    asm volatile("s_waitcnt lgkmcnt(0)" ::: "memory");
#pragma unroll
    for (int i = 0; i < 16; ++i) { const int id = i * 64 + lane, t = id >> 3, ch = id & 7; const v4u mv = *(const LAS v4u*)(mx + t * 64 + ch * 8); const float bsv = bs[g * 128 + t]; v4u o;
#pragma unroll
        for (int e = 0; e < 4; ++e) o[e] = pk2(bf2f(uc[i][e] & 0xffffu) * (bf2f(mv[e] & 0xffffu) + bsv), bf2f(uc[i][e] >> 16) * (bf2f(mv[e] >> 16) + bsv));
        *(v4u*)(Y + (size_t)(row0 + t) * 1024 + 512 + g * 64 + ch * 8) = o; }
    asm volatile("s_waitcnt lgkmcnt(0)" ::: "memory");
}

template <int step> __device__ __forceinline__ void do_step(const Args& args, unsigned char* lds, const int wv_) {
    LAS unsigned char* ldsl = (LAS unsigned char*)lds;
    int tid_ = (mk_lane()+((wv_)<<6)); asm volatile("" : "+v"(tid_));
    const int tid = tid_, lane = tid & 63, wave = __builtin_amdgcn_readfirstlane(tid >> 6);
    const int G = gridDim.x, bx = blockIdx.x;
    const int vcu = (G % 8 == 0) ? (bx % 8) * (G / 8) + bx / 8 : bx;
    const int gw = vcu * NWAVES + wave, NGW = G * NWAVES;
    unsigned char* ws = args.ws;
    float* rope = (float*)(ws + WS_ROPE); float* kmean = (float*)(ws + WS_KMEAN); float* ss = (float*)(ws + WS_SS);
    u16* Wsb = (u16*)(ws + WS_WSB); u16* Wc = (u16*)(ws + WS_W); u16* XB = (u16*)(ws + WS_XB); u16* HB = (u16*)(ws + WS_H);
    float* out = args.out;
    (void)rope; (void)kmean; (void)ss; (void)Wsb; (void)Wc; (void)XB; (void)HB; (void)out; (void)gw; (void)NGW; (void)lane; (void)ldsl;
        if constexpr (PHON(0) && step == 0) {
            LAS float* scr = (LAS float*)(ldsl + wave * 16384);
            constexpr int I_GU = 16 * 176, I_DN = 44 * 32, I_EIN = 16 * 80, I_OUT = 16 * 32, I_OIN = 16 * 96;
            constexpr int NITEMS = 4 * I_GU + 4 * I_DN + I_EIN + I_OUT + I_OIN + I_OUT;
#ifndef P0REP_T
#define P0REP_T 1
#endif
#ifndef P0REP_X
#define P0REP_X 1
#endif
            for (int rep_t = 0; rep_t < P0REP_T; ++rep_t)
            for (int it = gw; it < NITEMS; it += NGW) {
                int r = it;
                if (r < 4 * I_GU) { const int f = r / I_GU; r -= f * I_GU; const int l = f >> 1, post = f & 1;
                    const int kb = r / 176, nb = r % 176, n0 = 32 * nb, c = n0 & 255, j0 = 128 * (n0 >> 8) + (c & 127);
                    const float* Wsrc = args.in[(post ? 7 : 2) + (c >= 128 ? 1 : 0)] + (size_t)l * 1024 * FF;
                    const float* gain = args.in[post ? 6 : 1] + l * 1024;
                    tr_item(Wsrc, 1024, FF, j0, false, gain, Wc + W_GU + (size_t)f * W_GU_SZ, n0, 64 * kb, scr, lane); continue; }
                r -= 4 * I_GU;
                if (r < 4 * I_DN) { const int f = r / I_DN; r -= f * I_DN; const int l = f >> 1, post = f & 1; const int kb = r / 32, nb = r % 32;
                    tr_item(args.in[post ? 9 : 4] + (size_t)l * FF * 1024, FF, 1024, 32 * nb, false, nullptr, Wc + W_DN + (size_t)f * W_DN_SZ, 32 * nb, 64 * kb, scr, lane); continue; }
                r -= 4 * I_DN;
                if (r < I_EIN) { const int kb = r / 80, nb = r % 80, n0 = 32 * nb;
                    tr_item(args.in[10], 1024, 2560, n0, (n0 < 1024) && ((n0 & 63) == 0), args.in[5], Wc + W_EIN, n0, 64 * kb, scr, lane); continue; }
                r -= I_EIN;
                if (r < I_OUT) { const int kb = r / 32, nb = r % 32; tr_item(args.in[11], 1024, 1024, 32 * nb, false, nullptr, Wc + W_EOUT, 32 * nb, 64 * kb, scr, lane); continue; }
                r -= I_OUT;
                if (r < I_OIN) { const int kb = r / 96, nb = r % 96, n0 = 32 * nb;
                    tr_item(args.in[16], 1024, 3072, n0, (n0 < 2048) && ((n0 & 63) == 0), args.in[5] + 1024, Wc + W_OIN, n0, 64 * kb, scr, lane); continue; }
                r -= I_OIN;
                { const int kb = r / 32, nb = r % 32; tr_item(args.in[17], 1024, 1024, 32 * nb, false, nullptr, Wc + W_OOUT, 32 * nb, 64 * kb, scr, lane); }
            }
            const int gt = vcu * 512 + tid, NGT = G * 512;
            for (int i = gt; i < 8192 * 8; i += NGT) { const int pos = i >> 3, k = i & 7;
                const float inv = 1.0f / powf(500000.0f, (float)(2 * k) / 16.0f); const float ang = (float)pos * inv;
                double t = (double)ang * 0.15915494309189535; t -= floor(t); const float fr = (float)t;
                rope[2 * i] = __builtin_amdgcn_cosf(fr); rope[2 * i + 1] = __builtin_amdgcn_sinf(fr); }
            for (int i = gt; i < BATCH * 32 * 512; i += NGT) kmean[i] = 0.f;
            if (gw == 0) { const float s1 = wave_sum(args.in[18][lane] * args.in[19][lane]), s2 = wave_sum(args.in[20][lane] * args.in[21][lane]);
                if (lane == 0) *(float*)(ws + WS_LAM) = expf(s1) - expf(s2) + 0.35550906759096927f; }
            for (int i = gt; i < 8 * 128 * 128; i += NGT) { const int t = (i >> 7) & 127, s = i & 127; Wsb[i] = (u16)f2bf(s <= t ? args.in[14][i] : 0.f); }
            const float* x = args.in[0];
            for (int rep_x = 0; rep_x < P0REP_X; ++rep_x)
            for (int m0 = 2 * gw; m0 < M; m0 += 2 * NGW) { f32x4 v[2][4];
#pragma unroll
                for (int q = 0; q < 2; ++q) { const f32x4* xr = (const f32x4*)(x + (size_t)(m0 + q) * 1024) + lane;
#pragma unroll
                    for (int j = 0; j < 4; ++j) v[q][j] = xr[64 * j]; }
#pragma unroll
                for (int q = 0; q < 2; ++q) { const int m = m0 + q; float s = 0.f;
#pragma unroll
                    for (int j = 0; j < 4; ++j) s += (v[q][j][0] * v[q][j][0] + v[q][j][1] * v[q][j][1]) + (v[q][j][2] * v[q][j][2] + v[q][j][3] * v[q][j][3]);
                    s = wave_sum(s);
                    v2u* o8 = (v2u*)(XB + (size_t)m * 1024) + lane;
#pragma unroll
                    for (int j = 0; j < 4; ++j) { v2u w; w.x = pk2(v[q][j][0], v[q][j][1]); w.y = pk2(v[q][j][2], v[q][j][3]); o8[64 * j] = w; }
                    if (lane < 16) ss[(size_t)m * 16 + lane] = (lane == 0) ? s : 0.f; } }
        } else if constexpr (PHON(1) && (step == 1 || step == 6 || step == 8 || step == 14)) {
            const int f = (step == 1) ? 0 : (step == 6) ? 1 : (step == 8) ? 2 : 3;
            pg8::Gemm g{XB, Wc + W_GU + (size_t)f * W_GU_SZ, M, 2 * FF, 1024}; pg8::StaticOrder S; S.init(M, 2 * FF, G, bx);
            pg8::EpiSwiglu E{HB, FF, ss};
            pg8::gemm_phase<pg8::EpiSwiglu, pg8::StaticOrder, true, true>(ldsl, g, S, E, wv_);
        } else if constexpr (PHON(2) && (step == 2 || step == 5 || step == 7 || step == 9 || step == 13 || step == 15)) {
            const u16* A; const u16* Bt; int K; float alpha = 0.5f;
            if (step == 2) { A = HB; Bt = Wc + W_DN; K = FF; }
            else if (step == 5) { A = (const u16*)(ws + WS_EY); Bt = Wc + W_EOUT; K = 1024; alpha = 1.0f; }
            else if (step == 7) { A = HB; Bt = Wc + W_DN + W_DN_SZ; K = FF; }
            else if (step == 9) { A = HB; Bt = Wc + W_DN + 2 * W_DN_SZ; K = FF; }
            else if (step == 13) { A = (const u16*)(ws + WS_O0); Bt = Wc + W_OOUT; K = 1024; alpha = 1.0f; }
            else { A = HB; Bt = Wc + W_DN + 3 * W_DN_SZ; K = FF; }
            pg8::Gemm g{A, Bt, M, 1024, K}; pg8::StaticOrder S; S.init(M, 1024, G, bx);
            pg8::EpiResid E{XB, ss, alpha};
            pg8::gemm_phase<pg8::EpiResid, pg8::StaticOrder, true, true>(ldsl, g, S, E, wv_);
        } else if constexpr (PHON(3) && (step == 3 || step == 10)) {
            const bool even = (step == 3); const int N = even ? 2560 : 3072;
            pg8::Gemm g{XB, Wc + (even ? W_EIN : W_OIN), M, N, 1024}; pg8::StaticOrder S; S.init(M, N, G, bx);
            pg8::EpiIn E{(u16*)(ws + (even ? WS_EQ : WS_OQ)), even ? (size_t)M * 512 : (size_t)M * 1024, even ? 2 : 4, ss, rope, even ? kmean : nullptr, C2Q};
            pg8::gemm_phase<pg8::EpiIn, pg8::StaticOrder, true, true>(ldsl, g, S, E, wv_);
        } else if constexpr (PHON(4) && step == 4) {
            const attn_body::bf16* Qe = (const attn_body::bf16*)(ws + WS_EQ); const attn_body::bf16* Ke = Qe + (size_t)M * 512; const attn_body::bf16* Ve = Ke + (size_t)M * 512;
            const u16* Ue = (const u16*)(ws + WS_EQ) + (size_t)3 * M * 512; const u16* Vge = Ue + (size_t)M * 512;
            u16* Y = (u16*)(ws + WS_EY);
            if (!NOATT) for (int it = 0; it < 4; ++it) { const int qd = vcu + (it >> 2) * G; if (qd >= 256) break; const int i = it & 3;
                const int bh = qd >> 3, s = qd & 7;
                const int qb = (i == 0) ? s : (i == 1) ? 15 - s : (i == 2) ? 16 + s : 31 - s;
                attn_body::attn_unit<8, 512, 1024, true>(bh >> 3, bh & 7, bh & 7, qb, Qe, Ke, Ve, (attn_body::bf16*)Y, (char*)lds, kmean, wv_); }
            __syncthreads();
#ifndef GMLPREP
#define GMLPREP 1
#endif
            for (int rep_ = 0; rep_ < GMLPREP; ++rep_) for (int c = vcu; c < 256; c += G)
                gmlp_unit(c, wave, lane, ldsl + wave * 17408, Ue, Vge, args.in[12], args.in[13], Wsb, args.in[15], Y);
        } else if constexpr (PHON(5) && step == 11) {
            const attn_body::bf16* Qo = (const attn_body::bf16*)(ws + WS_OQ); const attn_body::bf16* Ko = Qo + (size_t)M * 1024; const attn_body::bf16* Vo = Ko + (size_t)M * 1024;
            constexpr float linit = 0.35550906759096927f;
            for (int it = 0; ; ++it) { int b, h, c, qb, desc;
                if (G == 256) { if (it >= 8) break; const int x = vcu >> 5, j = vcu & 31, k = j & 15, bh = x * 4 + (it >> 2) * 2 + (j >> 4), u = it & 3; h = bh & 7; b = bh >> 3; c = u >> 1; qb = (u == 0 || u == 3) ? k : 31 - k; desc = u & 1; }
                else { const int tq = vcu + (it >> 1) * G; if (tq >= 1024) break; c = it & 1; qb = tq & 31; const int bh = tq >> 5; h = bh & 7; b = bh >> 3; desc = 0; }
                attn_body::attn_unit2<8, 1024>(b, 2 * h + c, h, qb, Qo, Ko, Vo, (attn_body::bf16*)(ws + WS_O0), (char*)lds, c, args.in[22], (const float*)(ws + WS_LAM), 1.0f - linit, desc, wv_); }
        } else if constexpr (PHON(6) && step == 12) {
        } else if constexpr (PHON(7) && step == 16) {
            const float* fg = args.in[23];
            for (int m0 = 2 * gw; m0 < M; m0 += 2 * NGW) { v2u w[2][4];
#pragma unroll
                for (int q = 0; q < 2; ++q) { const v2u* xr = (const v2u*)(XB + (size_t)(m0 + q) * 1024) + lane;
#pragma unroll
                    for (int j = 0; j < 4; ++j) w[q][j] = xr[64 * j]; }
#pragma unroll
                for (int q = 0; q < 2; ++q) { float s = 0.f; f32x4 v[4];
#pragma unroll
                    for (int j = 0; j < 4; ++j) { v[j] = (f32x4){bf2f(w[q][j].x & 0xffffu), bf2f(w[q][j].x >> 16), bf2f(w[q][j].y & 0xffffu), bf2f(w[q][j].y >> 16)};
                        s += (v[j][0] * v[j][0] + v[j][1] * v[j][1]) + (v[j][2] * v[j][2] + v[j][3] * v[j][3]); }
                    const float r = 1.0f / sqrtf(wave_sum(s) * (1.0f / 1024.0f) + 1e-6f);
                    f32x4* orow = (f32x4*)(out + (size_t)(m0 + q) * 1024) + lane;
#pragma unroll
                    for (int j = 0; j < 4; ++j) { const f32x4 gg = *((const f32x4*)fg + lane + 64 * j); orow[64 * j] = v[j] * r * gg; } } }
        }
}

__global__ void __launch_bounds__(NWAVES * 64, 2) mk_fwd(Args args) {
    extern __shared__ __attribute__((aligned(16))) unsigned char lds[];
    cg::grid_group grid = cg::this_grid();
    volatile LAS unsigned* MISC = (volatile LAS unsigned*)((LAS unsigned char*)lds + LDS_BYTES - 128);
    const int wv_ = __builtin_amdgcn_readfirstlane(threadIdx.x >> 6);
    if (threadIdx.x < 32) MISC[threadIdx.x] = 0u;
    __syncthreads();
#ifndef DUPMASK
#define DUPMASK 0
#endif
#ifndef EXTRASYNC
#define EXTRASYNC 0
#endif
    { unsigned* rdy = (unsigned*)(args.ws + WS_RDY);
      if (blockIdx.x == 0) { for (int i = threadIdx.x; i < 4096; i += NWAVES * 64) ((unsigned*)(args.ws + WS_BAR))[i] = 0u;
          __threadfence(); __syncthreads();
          if (threadIdx.x == 0) __hip_atomic_store(rdy, BAR_MAGIC, __ATOMIC_RELEASE, __HIP_MEMORY_SCOPE_AGENT); }
      if (threadIdx.x == 0) { while (__hip_atomic_load(rdy, __ATOMIC_RELAXED, __HIP_MEMORY_SCOPE_AGENT) != BAR_MAGIC) __builtin_amdgcn_s_sleep(2);
          __builtin_amdgcn_fence(__ATOMIC_ACQUIRE, "agent"); }
      __syncthreads(); }
    const XcdBarrier bar = xcd_barrier_post((unsigned*)(args.ws + WS_BAR), MISC + 8, wv_);
    if (args.ws == nullptr) grid.sync();
    do_step<0>(args, lds, wv_); xcd_barrier(bar, wv_);
#define STEP_(k) do_step<k>(args, lds, wv_); xcd_barrier(bar, wv_); if constexpr ((DUPMASK >> k) & 1) { do_step<k>(args, lds, wv_); xcd_barrier(bar, wv_); }
    STEP_(1) STEP_(2) STEP_(3) STEP_(4) STEP_(5) STEP_(6) STEP_(7) STEP_(8) STEP_(9) STEP_(10) STEP_(11) STEP_(13) STEP_(14) STEP_(15)
    for (int i = 0; i < EXTRASYNC; ++i) xcd_barrier(bar, wv_);
    if (blockIdx.x == 0 && wv_ == 0 && mk_lane() == 0) __hip_atomic_store((unsigned*)(args.ws + WS_RDY), 0u, __ATOMIC_RELAXED, __HIP_MEMORY_SCOPE_AGENT);
    do_step<16>(args, lds, wv_);
#undef STEP_
}

extern "C" void kernel_launch(void* const* d_in, const int* in_sizes, int n_in, void* d_out, int out_size, void* d_ws, size_t ws_size, hipStream_t stream) {
    static int grid = 0;
    if (grid == 0) {
        if (n_in != 24 || out_size != M * DMODEL || ws_size < WS_END) { fprintf(stderr, "kernel_launch: unexpected shapes (n_in %d out %d ws %zu)\n", n_in, out_size, ws_size); grid = -1; return; }
        int dev = 0, cus = 0, per_cu = 0;
        hipGetDevice(&dev); hipDeviceGetAttribute(&cus, hipDeviceAttributeMultiprocessorCount, dev);
        if (hipFuncSetAttribute((const void*)mk_fwd, hipFuncAttributeMaxDynamicSharedMemorySize, LDS_BYTES) != hipSuccess) { fprintf(stderr, "kernel_launch: hipFuncSetAttribute failed\n"); grid = -1; return; }
        if (hipOccupancyMaxActiveBlocksPerMultiprocessor(&per_cu, (const void*)mk_fwd, NWAVES * 64, LDS_BYTES) != hipSuccess || per_cu < 1) { fprintf(stderr, "kernel_launch: occupancy query says %d\n", per_cu); per_cu = 1; }
        (void)hipGetLastError();
        grid = cus * per_cu;
    }
    if (grid < 0) return;
    Args a{};
    for (int i = 0; i < 24; ++i) a.in[i] = (const float*)d_in[i];
    a.out = (float*)d_out; a.ws = (unsigned char*)d_ws;
    void* kargs[] = {&a};
    hipError_t e = hipLaunchCooperativeKernel((const void*)mk_fwd, dim3(grid), dim3(NWAVES * 64), kargs, LDS_BYTES, stream);
    if (e != hipSuccess) fprintf(stderr, "cooperative launch failed: %s (grid %d)\n", hipGetErrorString(e), grid);
}
```

```cpp
#include <hip/hip_runtime.h>
#include <hip/hip_cooperative_groups.h>
#include <hip/hip_bf16.h>
#include <cstdio>
#include <cstdint>
#include <cmath>
__device__ __forceinline__ int mk_lane(){ int l_; asm volatile("v_mbcnt_lo_u32_b32 %0, -1, 0\n\tv_mbcnt_hi_u32_b32 %0, -1, %0" : "=v"(l_)); return l_; }
namespace pg8 {
#define PG8_LAS __attribute__((address_space(3)))
typedef unsigned short bf16_t;
typedef short bf16x8 __attribute__((ext_vector_type(8)));
typedef float f32x4 __attribute__((ext_vector_type(4)));
typedef unsigned u32x4 __attribute__((ext_vector_type(4)));
constexpr int BM = 256, BK = 64, HALF = 128, HTB = HALF * BK * 2  , STAGE_BYTES = 8 * HTB, NXCD = 8, WGM = 8;

__host__ __device__ __forceinline__ int lds_byte(int r, int c) { const int st = (r >> 4) * 2 + (c >> 5), rr = r & 15, cc = c & 31, ob = rr * 64 + cc * 2; return st * 1024 + (ob ^ (((ob >> 9) & 1) << 5)); }
__host__ __device__ __forceinline__ void stage_rc(int b, int& R, int& C) { const int st = b / 1024, sb = b % 1024, swz = sb ^ (((sb >> 9) & 1) << 5); R = (st >> 1) * 16 + swz / 64; C = (st & 1) * 32 + (swz % 64) / 2; }
__host__ __device__ __forceinline__ int perm32(int rho) { const int n = rho >> 4, i = rho & 15; return 8 * (i >> 2) + 4 * n + (i & 3); }

struct Unit { int pm, pn; };
struct Gemm { const bf16_t* A; const bf16_t* Bt; int M, N, K; };

struct StaticOrder {
    int nM, nN, nwg, G, c;
    __host__ __device__ void init(int M, int N, int G_, int c_) { nM = M / BM; nN = N / BM; nwg = nM * nN; G = G_; c = c_; }
    __host__ __device__ bool next(int i, Unit& u) const {
        const long L = (long)i * G + c; if (L >= nwg) return false;
        int wgid = (int)L; { const int q = nwg / NXCD, r = nwg % NXCD, xcd = wgid % NXCD, off = wgid / NXCD; wgid = (xcd < r ? xcd * (q + 1) : r * (q + 1) + (xcd - r) * q) + off; }
        const int nig = WGM * nN, gid = wgid / nig, fm = gid * WGM, gsz = (nM - fm) < WGM ? (nM - fm) : WGM;
        u.pm = fm + ((wgid % nig) % gsz); u.pn = (wgid % nig) / gsz; return true;
    }
    __device__ __forceinline__ void a_ready(const Unit&) const {}
    __device__ __forceinline__ void done(const Unit&) const {}
};

__device__ __forceinline__ unsigned cvt_pk_bf16(float lo, float hi) { unsigned r; asm volatile("v_cvt_pk_bf16_f32 %0, %1, %2" : "=v"(r) : "v"(lo), "v"(hi)); return r; }
typedef float f32x2 __attribute__((ext_vector_type(2)));
__device__ __forceinline__ f32x2 gelu_pk(f32x2 v) {
    const f32x2 av = __builtin_elementwise_abs(v), d = av * 0.2316418882f + 1.0f;
    f32x2 t; t.x = __builtin_amdgcn_rcpf(d.x); t.y = __builtin_amdgcn_rcpf(d.y);
    f32x2 q = t * 0.5307027145f + (-0.7265760135f); q = q * t + 0.7107068705f; q = q * t + (-0.142248368f); q = q * t + 0.127414796f; q = q * t;
    const f32x2 s = (v * v) * (-0.72134752044f);
    f32x2 e; e.x = __builtin_amdgcn_exp2f(s.x); e.y = __builtin_amdgcn_exp2f(s.y);
    const f32x2 m = v * (q * e), r = v - m;
    f32x2 o; o.x = v.x < 0.f ? m.x : r.x; o.y = v.y < 0.f ? m.y : r.y; return o;
}

template <int ACT  > struct EpiBf16 {
    static constexpr bool PERM = true, AFTER_DRAIN = false; static_assert(ACT == 0 || ACT == 1, "EpiBf16: ACT is 0 (none) or 1 (gelu_pk)");
    bf16_t* O; int ldc; const float* bias; int split_cols; size_t split_stride; float scale0;
    __device__ __forceinline__ void operator()(const f32x4 (&acc)[2][2][4][2], const Unit& u, int wr, int wc, int fr, int fq) const {
        const int row0 = u.pm * BM + wr * 64 + fr; int colt = u.pn * BM; bf16_t* base = O;
        float sc = 1.f; if (split_cols) { const int t = colt / split_cols; base += (size_t)t * split_stride; colt -= t * split_cols; if (t == 0) sc = scale0; }
        const int col0 = colt + wc * 32 + 8 * fq, bcol0 = u.pn * BM + wc * 32 + 8 * fq;
        f32x4 bv[2][2];
#pragma unroll
        for (int bj = 0; bj < 2; ++bj)
#pragma unroll
            for (int n = 0; n < 2; ++n) bv[bj][n] = bias ? *(const f32x4*)(bias + bcol0 + bj * HALF + 4 * n) : (f32x4){0.f, 0.f, 0.f, 0.f};
#pragma unroll
        for (int ai = 0; ai < 2; ++ai)
#pragma unroll
            for (int m = 0; m < 4; ++m) { bf16_t* rowp = base + (size_t)(row0 + ai * HALF + m * 16) * ldc + col0;
#pragma unroll
                for (int bj = 0; bj < 2; ++bj) { f32x4 v0 = acc[ai][bj][m][0] + bv[bj][0], v1 = acc[ai][bj][m][1] + bv[bj][1];
                    if (ACT == 1) { f32x2 a = gelu_pk((f32x2){v0[0], v0[1]}), b = gelu_pk((f32x2){v0[2], v0[3]}), c = gelu_pk((f32x2){v1[0], v1[1]}), d = gelu_pk((f32x2){v1[2], v1[3]});
                        v0 = (f32x4){a.x, a.y, b.x, b.y}; v1 = (f32x4){c.x, c.y, d.x, d.y}; }
                    v0 = v0 * sc; v1 = v1 * sc; u32x4 w; w.x = cvt_pk_bf16(v0[0], v0[1]); w.y = cvt_pk_bf16(v0[2], v0[3]); w.z = cvt_pk_bf16(v1[0], v1[1]); w.w = cvt_pk_bf16(v1[2], v1[3]);
                    *(u32x4*)(rowp + bj * HALF) = w; } }
    }
};

typedef unsigned u32x2 __attribute__((ext_vector_type(2)));
constexpr int SLOTS = 16;
constexpr float RMS_EPS = 1e-6f;
__device__ __forceinline__ void load_rstd(const float* ss, int row0, int fq, float (&rs)[2][4]) {
#pragma unroll
    for (int ai = 0; ai < 2; ++ai)
#pragma unroll
        for (int m = 0; m < 4; ++m) { const f32x4 a = *(const f32x4*)(ss + (size_t)(row0 + ai * HALF + m * 16) * SLOTS + 4 * fq);
            float s = (a[0] + a[1]) + (a[2] + a[3]); s += __shfl_xor(s, 16); s += __shfl_xor(s, 32);
            rs[ai][m] = __builtin_amdgcn_rsqf(s * (1.0f / 1024.0f) + RMS_EPS); }
}
__device__ __forceinline__ float silu_f(float g) { return g * __builtin_amdgcn_rcpf(1.0f + __builtin_amdgcn_exp2f(-1.4426950408889634f * g)); }
__device__ __forceinline__ float gelu_t(float x) { const float y = x * (1.0f + 0.044715f * x * x); return x * __builtin_amdgcn_rcpf(1.0f + __builtin_amdgcn_exp2f(-2.302208198f * y)); }

typedef float f32x2 __attribute__((ext_vector_type(2)));
__device__ __forceinline__ f32x2 swiglu_pk(f32x2 g, f32x2 u, f32x2 r2, f32x2 c2) {
    const f32x2 t = g * c2, gg = g * r2, uu = u * r2; f32x2 e; e.x = __builtin_amdgcn_exp2f(t.x); e.y = __builtin_amdgcn_exp2f(t.y);
    const f32x2 d = e + 1.0f; f32x2 sg; sg.x = __builtin_amdgcn_rcpf(d.x); sg.y = __builtin_amdgcn_rcpf(d.y);
    return (gg * sg) * uu;
}
struct EpiSwiglu {
    static constexpr bool PERM = true, AFTER_DRAIN = false;
    bf16_t* H; int ldh; const float* ss;
    __device__ __forceinline__ void operator()(const f32x4 (&acc)[2][2][4][2], const Unit& u, int wr, int wc, int fr, int fq) const {
        const int row0 = u.pm * BM + wr * 64 + fr; float rs[2][4]; load_rstd(ss, row0, fq, rs);
        const int col0 = u.pn * HALF + wc * 32 + 8 * fq;
#pragma unroll
        for (int ai = 0; ai < 2; ++ai)
#pragma unroll
            for (int m = 0; m < 4; ++m) { const float r = rs[ai][m]; bf16_t* p = H + (size_t)(row0 + ai * HALF + m * 16) * ldh + col0;
                const f32x2 r2 = (f32x2){r, r}, c2 = r2 * (-1.4426950408889634f);
                const f32x4 g0 = acc[ai][0][m][0], g1 = acc[ai][0][m][1], u0 = acc[ai][1][m][0], u1 = acc[ai][1][m][1];
                const f32x2 h0 = swiglu_pk((f32x2){g0[0], g0[1]}, (f32x2){u0[0], u0[1]}, r2, c2), h1 = swiglu_pk((f32x2){g0[2], g0[3]}, (f32x2){u0[2], u0[3]}, r2, c2);
                const f32x2 h2 = swiglu_pk((f32x2){g1[0], g1[1]}, (f32x2){u1[0], u1[1]}, r2, c2), h3 = swiglu_pk((f32x2){g1[2], g1[3]}, (f32x2){u1[2], u1[3]}, r2, c2);
                u32x4 w; w.x = cvt_pk_bf16(h0.x, h0.y); w.y = cvt_pk_bf16(h1.x, h1.y); w.z = cvt_pk_bf16(h2.x, h2.y); w.w = cvt_pk_bf16(h3.x, h3.y);
                *(u32x4*)p = w; }
    }
};
struct EpiResid {
    static constexpr bool PERM = true, AFTER_DRAIN = false;
    bf16_t* xb; float* ss; float alpha;
    __device__ __forceinline__ void operator()(const f32x4 (&acc)[2][2][4][2], const Unit& u, int wr, int wc, int fr, int fq) const {
        const int row0 = u.pm * BM + wr * 64 + fr, col0 = u.pn * BM + wc * 32 + 8 * fq;
#pragma unroll
        for (int ai = 0; ai < 2; ++ai)
#pragma unroll
            for (int m = 0; m < 4; ++m) { const int row = row0 + ai * HALF + m * 16; const size_t off = (size_t)row * 1024 + col0; float q = 0.f;
#pragma unroll
                for (int bj = 0; bj < 2; ++bj) { u32x4* p = (u32x4*)(xb + off + bj * HALF); const u32x4 bw = *p;
                    const f32x4 b0 = (f32x4){__builtin_bit_cast(float, bw.x << 16), __builtin_bit_cast(float, bw.x & 0xffff0000u), __builtin_bit_cast(float, bw.y << 16), __builtin_bit_cast(float, bw.y & 0xffff0000u)};
                    const f32x4 b1 = (f32x4){__builtin_bit_cast(float, bw.z << 16), __builtin_bit_cast(float, bw.z & 0xffff0000u), __builtin_bit_cast(float, bw.w << 16), __builtin_bit_cast(float, bw.w & 0xffff0000u)};
                    const f32x4 o0 = b0 + acc[ai][bj][m][0] * alpha, o1 = b1 + acc[ai][bj][m][1] * alpha;
                    q += ((o0[0] * o0[0] + o0[1] * o0[1]) + (o0[2] * o0[2] + o0[3] * o0[3])) + ((o1[0] * o1[0] + o1[1] * o1[1]) + (o1[2] * o1[2] + o1[3] * o1[3]));
                    u32x4 w; w.x = cvt_pk_bf16(o0[0], o0[1]); w.y = cvt_pk_bf16(o0[2], o0[3]); w.z = cvt_pk_bf16(o1[0], o1[1]); w.w = cvt_pk_bf16(o1[2], o1[3]); *p = w; }
                q += __shfl_xor(q, 16); q += __shfl_xor(q, 32);
                if (fq == 0) ss[(size_t)row * SLOTS + u.pn * 4 + wc] = q;
                if (m & 1) asm volatile("" ::: "memory"); }
    }
};
struct EpiIn {
    static constexpr bool PERM = true, AFTER_DRAIN = false;
    bf16_t* dst; size_t sec_stride; int ntq; const float* ss; const float* rope; float* kmean; float qscale;
    __device__ __forceinline__ void operator()(const f32x4 (&acc)[2][2][4][2], const Unit& u, int wr, int wc, int fr, int fq) const {
        const int sec = u.pn / ntq, tcol = (u.pn - sec * ntq) * BM, pitch = ntq * BM;
        bf16_t* basep = dst + (size_t)sec * sec_stride;
        const int row0 = u.pm * BM + wr * 64 + fr; float rs[2][4]; load_rstd(ss, row0, fq, rs);
        const int col0 = tcol + wc * 32 + 8 * fq;
        const bool ropelane = (sec < 2) && ((wc & 1) == 0) && (fq < 2);
        const float qs = (sec == 0) ? qscale : 1.0f;
        const bool dokm = (sec == 1) && (kmean != nullptr);
        f32x4 ks[2][2];
#pragma unroll
        for (int bj = 0; bj < 2; ++bj)
#pragma unroll
            for (int n = 0; n < 2; ++n) ks[bj][n] = (f32x4){0.f, 0.f, 0.f, 0.f};
#pragma unroll
        for (int ai = 0; ai < 2; ++ai) {
            f32x4 csv[4][2];
#pragma unroll
            for (int m = 0; m < 4; ++m) { csv[m][0] = (f32x4){1.f, 0.f, 1.f, 0.f}; csv[m][1] = csv[m][0];
                if (ropelane) { const float* rp = rope + ((size_t)((row0 + ai * HALF + m * 16) & 8191) * 8 + 4 * fq) * 2; csv[m][0] = *(const f32x4*)rp; csv[m][1] = *(const f32x4*)(rp + 4); } }
#pragma unroll
            for (int m = 0; m < 4; ++m) { const int row = row0 + ai * HALF + m * 16; const float r = rs[ai][m]; bf16_t* rowp = basep + (size_t)row * pitch + col0;
                const f32x4 cs0 = csv[m][0], cs1 = csv[m][1];
#pragma unroll
                for (int bj = 0; bj < 2; ++bj) { f32x4 v0 = acc[ai][bj][m][0] * r, v1 = acc[ai][bj][m][1] * r;
                    if (sec < 2) {
                        if (ropelane) {
                            const f32x4 a = v0, b = v1;
                            v0 = (f32x4){a[0] * cs0[0] - a[1] * cs0[1], a[0] * cs0[1] + a[1] * cs0[0], a[2] * cs0[2] - a[3] * cs0[3], a[2] * cs0[3] + a[3] * cs0[2]};
                            v1 = (f32x4){b[0] * cs1[0] - b[1] * cs1[1], b[0] * cs1[1] + b[1] * cs1[0], b[2] * cs1[2] - b[3] * cs1[3], b[2] * cs1[3] + b[3] * cs1[2]};
                        }
                        v0 = v0 * qs; v1 = v1 * qs;
                        if (dokm) { ks[bj][0] += v0; ks[bj][1] += v1; }
                    } else if (sec >= 3) {
                        v0 = (f32x4){gelu_t(v0[0]), gelu_t(v0[1]), gelu_t(v0[2]), gelu_t(v0[3])}; v1 = (f32x4){gelu_t(v1[0]), gelu_t(v1[1]), gelu_t(v1[2]), gelu_t(v1[3])};
                    }
                    u32x4 w; w.x = cvt_pk_bf16(v0[0], v0[1]); w.y = cvt_pk_bf16(v0[2], v0[3]); w.z = cvt_pk_bf16(v1[0], v1[1]); w.w = cvt_pk_bf16(v1[2], v1[3]);
                    *(u32x4*)(rowp + bj * HALF) = w; } }
            asm volatile("" ::: "memory"); }
        if (dokm) {
#pragma unroll
            for (int bj = 0; bj < 2; ++bj)
#pragma unroll
                for (int n = 0; n < 2; ++n)
#pragma unroll
                    for (int j = 0; j < 4; ++j) { float s = ks[bj][n][j]; s += __shfl_xor(s, 1); s += __shfl_xor(s, 2); s += __shfl_xor(s, 4); s += __shfl_xor(s, 8);
                        if (fr == 0) atomicAdd(kmean + (size_t)u.pm * 512 + col0 + bj * HALF + 4 * n + j, s * (1.0f / 256.0f)); }
        }
    }
};

template <class Epi, class Sched, bool ALIGN_EPI = false, bool SP2 = false>
__device__ __forceinline__ void gemm_phase(PG8_LAS unsigned char* lds, const Gemm g, const Sched& S, const Epi& E, const int wv_  ) {
    int tid_ = (mk_lane()+((wv_)<<6)); asm volatile("" : "+v"(tid_));
    const int tid = tid_, wid = __builtin_amdgcn_readfirstlane(tid >> 6), lane = tid & 63, wr = wid >> 2, wc = wid & 3, fr = lane & 15, fq = lane >> 4;
    const int K = g.K, nt = K / BK;
    unsigned voffA[2], voffB[2];
#pragma unroll
    for (int i = 0; i < 2; ++i) { int R, C; stage_rc(tid * 16 + i * 8192, R, C); const int Rb = Epi::PERM ? ((R & ~31) + perm32(R & 31)) : R;
        voffA[i] = (unsigned)(R * K + C) * 2u; voffB[i] = (unsigned)(Rb * K + C) * 2u; }
    const size_t kstep = (size_t)(BK * 2);
    const size_t hstep = (size_t)HALF * K * 2;
    const size_t tstep = 2 * hstep;
    const unsigned ldsw = (unsigned)wid * 1024u;
    const int aoff = lds_byte(wr * 64 + fr, fq * 8), boff = lds_byte(wc * 32 + fr, fq * 8);
#define PG8_SA(b, h) (((b) * 2 + (h)) * HTB)
#define PG8_SB(b, h) ((4 + (b) * 2 + (h)) * HTB)
#define PG8_STAGE(bufoff, gbase, voff) do { _Pragma("unroll") for (int _i = 0; _i < 2; ++_i) \
        __builtin_amdgcn_global_load_lds((const unsigned*)((const char*)(gbase) + (voff)[_i]), (PG8_LAS unsigned*)(lds + (bufoff) + ldsw + _i * 8192), 16, 0, 0); } while (0)
#define PG8_LDA(dst, b, h) do { _Pragma("unroll") for (int m = 0; m < 4; ++m) _Pragma("unroll") for (int k = 0; k < 2; ++k) dst[m][k] = *(const PG8_LAS bf16x8*)(lds + PG8_SA(b, h) + aoff + m * 2048 + k * 1024); } while (0)
#define PG8_LDB(dst, b, h) do { _Pragma("unroll") for (int n = 0; n < 2; ++n) _Pragma("unroll") for (int k = 0; k < 2; ++k) dst[n][k] = *(const PG8_LAS bf16x8*)(lds + PG8_SB(b, h) + boff + n * 2048 + k * 1024); } while (0)
#define PG8_MMA(ai, bj, At, Bt) do { __builtin_amdgcn_s_setprio(1); _Pragma("unroll") for (int m = 0; m < 4; ++m) _Pragma("unroll") for (int n = 0; n < 2; ++n) _Pragma("unroll") for (int k = 0; k < 2; ++k) \
        acc[ai][bj][m][n] = __builtin_amdgcn_mfma_f32_16x16x32_bf16(Bt[n][k], At[m][k], acc[ai][bj][m][n], 0, 0, 0); __builtin_amdgcn_s_setprio(0); } while (0)
#define PG8_WAIT_V(n) asm volatile("s_waitcnt vmcnt(" #n ")" ::: "memory")
#define PG8_WAIT_L(n) asm volatile("s_waitcnt lgkmcnt(" #n ")" ::: "memory")
#define PG8_BAR __builtin_amdgcn_s_barrier()
#define PG8_SCHED __builtin_amdgcn_sched_barrier(0)
    Unit cur, nxt; int ui = 0;
    if (!S.next(0, cur)) return;
    f32x4 acc[2][2][4][2];
#pragma unroll
    for (int a = 0; a < 2; ++a)
#pragma unroll
        for (int b = 0; b < 2; ++b)
#pragma unroll
            for (int m = 0; m < 4; ++m)
#pragma unroll
                for (int n = 0; n < 2; ++n) acc[a][b][m][n] = (f32x4){0.f, 0.f, 0.f, 0.f};
    bf16x8 At[4][2], B0[2][2], B1[2][2];
    const char* cA = (const char*)g.A + (size_t)cur.pm * tstep; const char* cB = (const char*)g.Bt + (size_t)cur.pn * tstep;
    S.a_ready(cur);
    if constexpr (SP2) {
        PG8_STAGE(PG8_SB(0, 0), cB, voffB); PG8_STAGE(PG8_SB(0, 1), cB + hstep, voffB); PG8_STAGE(PG8_SA(0, 0), cA, voffA); PG8_STAGE(PG8_SA(0, 1), cA + hstep, voffA);
        if (wr == 1) PG8_BAR;
        PG8_WAIT_V(2); PG8_BAR;
        PG8_STAGE(PG8_SB(1, 0), cB + kstep, voffB); PG8_STAGE(PG8_SA(1, 0), cA + kstep, voffA); PG8_STAGE(PG8_SB(1, 1), cB + hstep + kstep, voffB);
        PG8_WAIT_V(6); PG8_BAR;
    } else {
        PG8_STAGE(PG8_SB(0, 0), cB, voffB); PG8_STAGE(PG8_SA(0, 0), cA, voffA); PG8_STAGE(PG8_SB(0, 1), cB + hstep, voffB); PG8_STAGE(PG8_SA(0, 1), cA + hstep, voffA);
        if (wr == 1) PG8_BAR;
        PG8_WAIT_V(4); PG8_BAR;
        PG8_STAGE(PG8_SB(1, 0), cB + kstep, voffB); PG8_STAGE(PG8_SA(1, 0), cA + kstep, voffA); PG8_STAGE(PG8_SB(1, 1), cB + hstep + kstep, voffB);
        PG8_WAIT_V(6); PG8_BAR;
    }
    for (;;) {
        const bool has_next = S.next(ui + 1, nxt);
        const char* nA = has_next ? (const char*)g.A + (size_t)nxt.pm * tstep : cA; const char* nB = has_next ? (const char*)g.Bt + (size_t)nxt.pn * tstep : cB;
        for (int t = 0; t < nt; t += 2) {
            const bool last = (t == nt - 2);
            const char* a1 = cA + (size_t)(t + 1) * kstep;
            const char* a2 = last ? nA : cA + (size_t)(t + 2) * kstep; const char* b2 = last ? nB : cB + (size_t)(t + 2) * kstep;
            const char* a3 = a2 + kstep; const char* b3 = b2 + kstep;
            if (last && has_next) S.a_ready(nxt);
            if constexpr (SP2) {
            PG8_LDB(B0, 0, 0); PG8_LDB(B1, 0, 1); PG8_SCHED; PG8_LDA(At, 0, 0); PG8_STAGE(PG8_SA(1, 1), a1 + hstep, voffA);
            PG8_WAIT_V(8); PG8_WAIT_L(0); PG8_BAR; PG8_MMA(0, 0, At, B0); PG8_MMA(0, 1, At, B1); PG8_BAR; PG8_SCHED;
            PG8_LDA(At, 0, 1); PG8_STAGE(PG8_SB(0, 0), b2, voffB); PG8_STAGE(PG8_SB(0, 1), b2 + hstep, voffB); PG8_STAGE(PG8_SA(0, 0), a2, voffA);
            PG8_WAIT_V(8); PG8_WAIT_L(0); PG8_BAR; PG8_MMA(1, 0, At, B0); PG8_MMA(1, 1, At, B1); PG8_BAR; PG8_SCHED;
            PG8_LDB(B0, 1, 0); PG8_LDB(B1, 1, 1); PG8_SCHED; PG8_LDA(At, 1, 0); PG8_STAGE(PG8_SA(0, 1), a2 + hstep, voffA);
            PG8_WAIT_V(8); PG8_WAIT_L(0); PG8_BAR; PG8_MMA(0, 0, At, B0); PG8_MMA(0, 1, At, B1); PG8_BAR; PG8_SCHED;
            PG8_LDA(At, 1, 1); PG8_STAGE(PG8_SB(1, 0), b3, voffB); PG8_STAGE(PG8_SB(1, 1), b3 + hstep, voffB); PG8_STAGE(PG8_SA(1, 0), a3, voffA);
            PG8_WAIT_V(8); PG8_WAIT_L(0); PG8_BAR; PG8_MMA(1, 0, At, B0); PG8_MMA(1, 1, At, B1); PG8_BAR; PG8_SCHED;
            } else {
            PG8_LDB(B0, 0, 0); PG8_SCHED; PG8_LDA(At, 0, 0); PG8_STAGE(PG8_SA(1, 1), a1 + hstep, voffA);
            PG8_WAIT_L(8); PG8_BAR; PG8_WAIT_L(0); PG8_MMA(0, 0, At, B0); PG8_BAR; PG8_SCHED;
            PG8_LDB(B1, 0, 1); PG8_STAGE(PG8_SB(0, 0), b2, voffB);
            PG8_BAR; PG8_WAIT_L(0); PG8_MMA(0, 1, At, B1); PG8_BAR;
            PG8_LDA(At, 0, 1); PG8_STAGE(PG8_SA(0, 0), a2, voffA);
            PG8_BAR; PG8_WAIT_L(0); PG8_MMA(1, 0, At, B0); PG8_BAR; PG8_SCHED;
            PG8_STAGE(PG8_SB(0, 1), b2 + hstep, voffB);
            PG8_WAIT_V(6); PG8_BAR; PG8_MMA(1, 1, At, B1); PG8_BAR;
            PG8_LDB(B0, 1, 0); PG8_SCHED; PG8_LDA(At, 1, 0); PG8_STAGE(PG8_SA(0, 1), a2 + hstep, voffA);
            PG8_WAIT_L(8); PG8_BAR; PG8_WAIT_L(0); PG8_MMA(0, 0, At, B0); PG8_BAR; PG8_SCHED;
            PG8_LDB(B1, 1, 1); PG8_STAGE(PG8_SB(1, 0), b3, voffB);
            PG8_BAR; PG8_WAIT_L(0); PG8_MMA(0, 1, At, B1); PG8_BAR;
            PG8_LDA(At, 1, 1); PG8_STAGE(PG8_SA(1, 0), a3, voffA);
            PG8_BAR; PG8_WAIT_L(0); PG8_MMA(1, 0, At, B0); PG8_BAR; PG8_SCHED;
            PG8_STAGE(PG8_SB(1, 1), b3 + hstep, voffB);
            PG8_WAIT_V(6); PG8_BAR; PG8_MMA(1, 1, At, B1); PG8_BAR;
            }
        }
        if constexpr (ALIGN_EPI) { if (wr == 0) PG8_BAR; }
        if constexpr (!Epi::AFTER_DRAIN) { E(acc, cur, wr, wc, fr, fq); S.done(cur); }
        if (!has_next) break;
#pragma unroll
        for (int a = 0; a < 2; ++a)
#pragma unroll
            for (int b = 0; b < 2; ++b)
#pragma unroll
                for (int m = 0; m < 4; ++m)
#pragma unroll
                    for (int n = 0; n < 2; ++n) acc[a][b][m][n] = (f32x4){0.f, 0.f, 0.f, 0.f};
        cur = nxt; cA = nA; cB = nB; ++ui;
        if constexpr (ALIGN_EPI) { if (wr == 1) PG8_BAR; }
    }
    PG8_WAIT_V(0);
    if constexpr (!ALIGN_EPI) { if (wr == 0) PG8_BAR; }
    PG8_BAR;
    if constexpr (Epi::AFTER_DRAIN) { E.fused(acc, cur, wr, wc, fr, fq, lds, wid, lane); S.done(cur); }
#undef PG8_SA
#undef PG8_SB
#undef PG8_STAGE
#undef PG8_LDA
#undef PG8_LDB
#undef PG8_MMA
#undef PG8_WAIT_V
#undef PG8_WAIT_L
#undef PG8_BAR
#undef PG8_SCHED
}
}
namespace attn_body {
using bf16=__hip_bfloat16;
using bf16x8=__attribute__((ext_vector_type(8)))short;
using s16x4=__attribute__((ext_vector_type(4)))short;
using f32x16=__attribute__((ext_vector_type(16)))float;
using u32x4=__attribute__((ext_vector_type(4)))unsigned;
using f32x4m=__attribute__((ext_vector_type(4)))float;
constexpr int SEQ=8192,D=64;
constexpr int NW=8,QBLK=32,QB=QBLK*NW,KVBLK=64,NQB=SEQ/QB;

__device__ __forceinline__ int crow(int r,int hi){return (r&3)+8*(r>>2)+4*hi;}
#define SBAR() __builtin_amdgcn_sched_barrier(0)
__device__ __forceinline__ void cmask(f32x16&p0,f32x16&p1,int jb,int qrel,int hi){
  asm volatile("":"+v"(hi));
  const float NEG=-INFINITY; int kb=64*jb+4*hi;
  #pragma unroll
  for(int r=0;r<16;++r){int kv=kb+(r&3)+8*(r>>2); if(kv>qrel)p0[r]=NEG; if(kv+32>qrel)p1[r]=NEG;}
}

constexpr int NSLOT=3, SLOTB=8192;
constexpr int LDS_K=0, LDS_V=NSLOT*SLOTB, LDS_WS=2*NSLOT*SLOTB, LDS_OST=LDS_WS+NW*64*4, LDS_BYTES=LDS_OST+NW*4096;
constexpr float C2=0.125f*1.4426950408889634f;
__device__ __forceinline__ void glds16(const void*gsrc,unsigned lds_dst){unsigned keep;
  asm volatile("s_mov_b32 %0, m0\n\ts_mov_b32 m0, %2\n\ts_nop 0\n\tglobal_load_lds_dwordx4 %1, off\n\ts_mov_b32 m0, %0":"=&s"(keep):"v"(gsrc),"s"(lds_dst):"memory");}
__device__ __forceinline__ float max3f(float a,float b,float c){float r;asm("v_max3_f32 %0, %1, %2, %3":"=v"(r):"v"(a),"v"(b),"v"(c));return r;}
__device__ __forceinline__ float max2f(float a,float b){float r;asm("v_max_f32_e32 %0, %1, %2":"=v"(r):"v"(a),"v"(b));return r;}
__device__ __forceinline__ float fadd_s(float a,float b){float r;asm("v_add_f32_e32 %0, %1, %2":"=v"(r):"v"(a),"v"(b));return r;}
__device__ __forceinline__ float fsub_s(float a,float b){float r;asm("v_sub_f32_e32 %0, %1, %2":"=v"(r):"v"(a),"v"(b));return r;}
typedef float f32x2_t __attribute__((ext_vector_type(2))); typedef __bf16 bf16x2_t __attribute__((ext_vector_type(2)));
__device__ __forceinline__ unsigned cvtpk_s(float lo,float hi){f32x2_t v={lo,hi};bf16x2_t b=__builtin_convertvector(v,bf16x2_t);return __builtin_bit_cast(unsigned,b);}
#define WAIT_BAR(N) asm volatile("s_waitcnt vmcnt(" #N ") lgkmcnt(0)\n\ts_barrier":::"memory")

__device__ __forceinline__ void qkt(f32x16&p0,f32x16&p1,const char*Kslot,const bf16x8*qr,const f32x16&negm,int r32,int hi){
  const char*kb=Kslot+hi*1024+r32*16;
  #pragma unroll
  for(int d0=0;d0<4;++d0){
    const bf16x8 b0=*reinterpret_cast<const bf16x8*>(kb+d0*2048);
    const bf16x8 b1=*reinterpret_cast<const bf16x8*>(kb+d0*2048+512);
    if(d0==0){p0=__builtin_amdgcn_mfma_f32_32x32x16_bf16(b0,qr[0],negm,0,0,0);p1=__builtin_amdgcn_mfma_f32_32x32x16_bf16(b1,qr[0],negm,0,0,0);}
    else{p0=__builtin_amdgcn_mfma_f32_32x32x16_bf16(b0,qr[d0],p0,0,0,0);p1=__builtin_amdgcn_mfma_f32_32x32x16_bf16(b1,qr[d0],p1,0,0,0);}}
}
typedef __attribute__((address_space(3))) const char* lds_cptr;
typedef short v4i16_t __attribute__((ext_vector_type(4)));
__device__ __forceinline__ void kload8(bf16x8*kf,lds_cptr kp){
  kf[0]=*(const __attribute__((address_space(3))) bf16x8*)(kp);      kf[1]=*(const __attribute__((address_space(3))) bf16x8*)(kp+512);
  kf[2]=*(const __attribute__((address_space(3))) bf16x8*)(kp+2048); kf[3]=*(const __attribute__((address_space(3))) bf16x8*)(kp+2560);
  kf[4]=*(const __attribute__((address_space(3))) bf16x8*)(kp+4096); kf[5]=*(const __attribute__((address_space(3))) bf16x8*)(kp+4608);
  kf[6]=*(const __attribute__((address_space(3))) bf16x8*)(kp+6144); kf[7]=*(const __attribute__((address_space(3))) bf16x8*)(kp+6656);
}
__device__ __forceinline__ void kload2(bf16x8*kf,lds_cptr kp,int j){ kf[2*j]=*(const __attribute__((address_space(3))) bf16x8*)(kp+j*2048); kf[2*j+1]=*(const __attribute__((address_space(3))) bf16x8*)(kp+j*2048+512); }
__device__ __forceinline__ s16x4 vtr(lds_cptr p){ return __builtin_bit_cast(s16x4,__builtin_amdgcn_ds_read_tr16_b64_v4i16((__attribute__((address_space(3))) v4i16_t*)p)); }
__device__ __forceinline__ float rowmax(const f32x16&p0,const f32x16&p1){
  float a=max3f(p0[0],p0[1],p1[0]),b=max3f(p0[2],p0[3],p1[1]);a=max3f(a,p1[2],p1[3]);
  #pragma unroll
  for(int r=4;r<16;r+=4){a=max3f(a,p0[r],p0[r+1]);b=max3f(b,p0[r+2],p0[r+3]);a=max3f(a,p1[r],p1[r+1]);b=max3f(b,p1[r+2],p1[r+3]);}
  const float m=max2f(a,b);
  auto rr=__builtin_amdgcn_permlane32_swap(__float_as_uint(m),__float_as_uint(m),false,false);
  return max2f(__uint_as_float(rr[0]),__uint_as_float(rr[1]));
}
__device__ __forceinline__ void pv(f32x16*o,int vb,bf16x8 pa0,bf16x8 pa1,bf16x8 pa2,bf16x8 pa3){
  #pragma unroll
  for(int d0=0;d0<2;++d0){s16x4 lo[4],hi[4];
    #pragma unroll
    for(int ks=0;ks<4;++ks){
      asm volatile("ds_read_b64_tr_b16 %0,%1 offset:%c2":"=&v"(lo[ks]):"v"(vb),"i"(d0*4096+ks*1024):"memory");
      asm volatile("ds_read_b64_tr_b16 %0,%1 offset:%c2":"=&v"(hi[ks]):"v"(vb),"i"(d0*4096+ks*1024+512):"memory");}
    asm volatile("s_waitcnt lgkmcnt(0)":::"memory");SBAR();
    #define PK(k) (bf16x8){lo[k][0],lo[k][1],lo[k][2],lo[k][3],hi[k][0],hi[k][1],hi[k][2],hi[k][3]}
    o[d0]=__builtin_amdgcn_mfma_f32_32x32x16_bf16(pa0,PK(0),o[d0],0,0,0);
    o[d0]=__builtin_amdgcn_mfma_f32_32x32x16_bf16(pa1,PK(1),o[d0],0,0,0);
    o[d0]=__builtin_amdgcn_mfma_f32_32x32x16_bf16(pa2,PK(2),o[d0],0,0,0);
    o[d0]=__builtin_amdgcn_mfma_f32_32x32x16_bf16(pa3,PK(3),o[d0],0,0,0);
    #undef PK
  }
}

#ifndef ATTN_STORE16
#define ATTN_STORE16(p,v) (*(u32x4*)(p)=(v))
#endif
template<int THRL,int DM,int DMO,bool MOBA> __device__ __forceinline__ void attn_unit(int b,int hq,int hv,int qb,const bf16*Q,const bf16*__restrict__ K,const bf16*__restrict__ V,bf16*O,char*shm,const float*kmean,const int wv_){
  int tid=(mk_lane()+((wv_)<<6)); asm volatile("":"+v"(tid));
  const int lane=tid&63,r32=lane&31,hi=lane>>5; const int wid=__builtin_amdgcn_readfirstlane(tid>>6);
  const long rowbase=(long)b*SEQ; const int q0=qb*QB;
  const bf16*Qw=Q+(rowbase+q0+wid*QBLK)*DM+hq*D;
  const bf16*Kh=K+rowbase*DM+hq*D,*Vh=V+rowbase*DM+hv*D;
  const unsigned lds0=(unsigned)(uintptr_t)shm;
  float*wsf=(float*)(shm+LDS_WS)+wid*64;
  const bf16*ksrc=Kh+(long)lane*DM+wid*8;
  const bf16*vsrc=Vh+(long)(16*(wid&3)+(lane>>2))*DM+(wid>>2)*32+(lane&3)*8;
  const unsigned kdst=lds0+LDS_K+wid*1024, vdst=lds0+LDS_V+wid*1024;
  #define DMA_K(t,slot) glds16(ksrc+(long)(t)*KVBLK*DM,(unsigned)__builtin_amdgcn_readfirstlane(kdst+(slot)))
  #define DMA_V(t,slot) glds16(vsrc+(long)(t)*KVBLK*DM,(unsigned)__builtin_amdgcn_readfirstlane(vdst+(slot)))
  const int vb0=(int)(lds0+LDS_V)+((lane>>4)&1)*32+(lane&3)*8+(4*hi+((lane&15)>>2))*64;
  const char*Kbase=shm+LDS_K; bf16x8 kf[8];
  const lds_cptr shm3=(lds_cptr)shm; const lds_cptr kp0=shm3+LDS_K+hi*1024+r32*16; const lds_cptr vp0=shm3+LDS_V+((lane>>4)&1)*32+(lane&3)*8+(4*hi+((lane&15)>>2))*64;
  const int NT=(q0+QB)/KVBLK;
  DMA_K(0,0);DMA_V(0,0);DMA_K(1,SLOTB);
  bf16x8 qr[4];
  #pragma unroll
  for(int d0=0;d0<4;++d0)qr[d0]=*reinterpret_cast<const bf16x8*>(&Qw[(long)r32*DM+d0*16+hi*8]);
  unsigned selmask=0u;
  if constexpr(MOBA){ if(qb>0){
    const float*km=kmean+((size_t)(b*32+r32))*512+hq*64+hi*8;
    f32x16 g=f32x16{};
    #pragma unroll
    for(int d0=0;d0<4;++d0){ const f32x4m ka=*reinterpret_cast<const f32x4m*>(km+d0*16), kb=*reinterpret_cast<const f32x4m*>(km+d0*16+4);
      u32x4 w; w[0]=cvtpk_s(ka[0],ka[1]); w[1]=cvtpk_s(ka[2],ka[3]); w[2]=cvtpk_s(kb[0],kb[1]); w[3]=cvtpk_s(kb[2],kb[3]);
      g=__builtin_amdgcn_mfma_f32_32x32x16_bf16(__builtin_bit_cast(bf16x8,w),qr[d0],g,0,0,0); }
    int hi2=hi; asm volatile("":"+v"(hi2));
    float m1=-INFINITY,m2=-INFINITY,m3=-INFINITY;
    #define INS3(v_) do{ float t_=(v_); const float n1_=fmaxf(m1,t_); t_=fminf(m1,t_); m1=n1_; const float n2_=fmaxf(m2,t_); t_=fminf(m2,t_); m2=n2_; m3=fmaxf(m3,t_); }while(0)
    #pragma unroll
    for(int r=0;r<16;++r){ const int j=crow(r,hi2); const float v=(j<qb)?g[r]:-INFINITY; g[r]=v; INS3(v); }
    { auto x1=__builtin_amdgcn_permlane32_swap(__float_as_uint(m1),__float_as_uint(m1),false,false); auto x2=__builtin_amdgcn_permlane32_swap(__float_as_uint(m2),__float_as_uint(m2),false,false);
      auto x3=__builtin_amdgcn_permlane32_swap(__float_as_uint(m3),__float_as_uint(m3),false,false);
      m1=-INFINITY; m2=-INFINITY; m3=-INFINITY;
      INS3(__uint_as_float(x1[0])); INS3(__uint_as_float(x1[1])); INS3(__uint_as_float(x2[0])); INS3(__uint_as_float(x2[1])); INS3(__uint_as_float(x3[0])); INS3(__uint_as_float(x3[1])); }
    #undef INS3
    unsigned mk=0u;
    #pragma unroll
    for(int r=0;r<16;++r){ const int j=crow(r,hi2); if(j<qb && g[r]>=m3) mk|=(1u<<j); }
    { auto xm=__builtin_amdgcn_permlane32_swap(mk,mk,false,false); mk=xm[0]|xm[1]; }
    selmask=mk; } }
  #define MBIAS(P0,P1,t,band) do{ if constexpr(MOBA){ const float bs_=((band)||((selmask>>((t)>>2))&1u))?-mhat:-1e30f; _Pragma("unroll") for(int r=0;r<16;++r){P0[r]+=bs_;P1[r]+=bs_;} } }while(0)
  float mhat=0.f,l_reg=0.f;f32x16 o[2];o[0]=f32x16{};o[1]=f32x16{};f32x16 negm=f32x16{};if constexpr(!MOBA){asm volatile("":"+v"(negm));}
  const int qrel=wid*QBLK+r32;
  #define CMASK(P0,P1,t) do{int jb_=(t)-(NT-4); MBIAS(P0,P1,t,jb_>=0); if(jb_>=0)cmask(P0,P1,jb_,qrel,hi);}while(0)
  bool resc=false;
  #define START(P0,P1) do{ const float rm=rowmax(P0,P1); resc=false; \
    { const float dl=MOBA?__builtin_fmaxf(rm,0.f):rm; mhat=fadd_s(mhat,dl);     \
      _Pragma("unroll") for(int r=0;r<16;++r){P0[r]=fsub_s(P0[r],dl);P1[r]=fsub_s(P1[r],dl);} \
      if constexpr(!MOBA){ _Pragma("unroll") for(int r=0;r<16;++r)negm[r]=-mhat; asm volatile("":"+v"(negm)); } } \
    _Pragma("unroll") for(int r=0;r<16;++r)P0[r]=__builtin_amdgcn_exp2f(P0[r]); }while(0)
  #define RESC() do{ if(resc){ asm volatile("s_waitcnt lgkmcnt(0)":::"memory"); \
      _Pragma("unroll") for(int d_=0;d_<2;++d_) _Pragma("unroll") for(int r=0;r<16;++r)o[d_][r]*=wsf[crow(r,hi)]; } }while(0)
  f32x16 pA0,pA1,pB0,pB1;
  int sl_prev=0,sl_cur=0,sl_next=SLOTB;
  #define ROT() do{sl_prev=sl_cur;sl_cur=sl_next;sl_next=(sl_next==(NSLOT-1)*SLOTB)?0:sl_next+SLOTB;}while(0)
  DMA_K(2,2*SLOTB);
  WAIT_BAR(3);
  qkt(pA0,pA1,Kbase,qr,negm,r32,hi);asm volatile("s_nop 15\n\ts_nop 7":"+v"(pA0),"+v"(pA1));CMASK(pA0,pA1,0);
  START(pA0,pA1);
  _Pragma("unroll") for(int r=0;r<16;++r)pA1[r]=__builtin_amdgcn_exp2f(pA1[r]);
  WAIT_BAR(0);
  DMA_K(3,0);DMA_V(1,SLOTB);
  ROT();
  kload8(kf,kp0+sl_cur);
  WAIT_BAR(2);
  s16x4 vlo[8],vhi[8]; u32x4 pw0,pw1,pw2,pw3;
  #define PKW(P,B) cvtpk_s(P[B],P[B+1])
  #define PAF(k) __builtin_bit_cast(bf16x8,pw##k)
  #define VFR(i) (bf16x8){vlo[i][0],vlo[i][1],vlo[i][2],vlo[i][3],vhi[i][0],vhi[i][1],vhi[i][2],vhi[i][3]}
  #define PIN(x) asm volatile("":"+v"(x))
  #define MX3(a,b,c) __builtin_fmaxf(__builtin_fmaxf((a),(b)),(c))
  #define GAPA(MF,A0,A1,A2,A3,W0,W1,PW) do{ MF; sacc+=A0; sacc+=A1; sacc+=A2; sacc+=A3; PIN(sacc); W0; W1; PIN(PW); SBAR(); }while(0)
  #define EX(v) __builtin_amdgcn_exp2f(v)
  #define GAPB(MF,X,B) do{ MF; X[B]=EX(X[B]); X[B+1]=EX(X[B+1]); X[B+2]=EX(X[B+2]); X[B+3]=EX(X[B+3]); PIN(X); SBAR(); }while(0)
  #define VRD(i) do{ vlo[i]=vtr(vp_+(((i)>>2)*4096+((i)&3)*1024)); vhi[i]=vtr(vp_+(((i)>>2)*4096+((i)&3)*1024+512)); }while(0)
  #define KRD(G,j) do{ if(G){ kload2(kf,kp0+sl_next,j); SBAR(); } }while(0)
  #define STEP(C0,C1,P0,P1,t,GK,GV,GL) do{ SBAR(); \
    const lds_cptr vp_=vp0+sl_prev; \
    VRD(0); SBAR(); float sacc=(P0[0]+P0[1]); \
    GAPA(C0=__builtin_amdgcn_mfma_f32_32x32x16_bf16(kf[0],qr[0],negm,0,0,0), P0[2],P0[3],P0[4],P0[5],     pw0[0]=PKW(P0,0), pw0[1]=PKW(P0,2), pw0); \
    VRD(4); SBAR(); GAPA(C1=__builtin_amdgcn_mfma_f32_32x32x16_bf16(kf[1],qr[0],negm,0,0,0), P0[6],P0[7],P0[8],P0[9],     pw0[2]=PKW(P0,4), pw0[3]=PKW(P0,6), pw0); \
    VRD(1); SBAR(); GAPA(C0=__builtin_amdgcn_mfma_f32_32x32x16_bf16(kf[2],qr[1],C0,0,0,0),   P0[10],P0[11],P0[12],P0[13], pw1[0]=PKW(P0,8), pw1[1]=PKW(P0,10), pw1); \
    VRD(5); SBAR(); GAPA(C1=__builtin_amdgcn_mfma_f32_32x32x16_bf16(kf[3],qr[1],C1,0,0,0),   P0[14],P0[15],P1[0],P1[1],   pw1[2]=PKW(P0,12),pw1[3]=PKW(P0,14), pw1); \
    VRD(2); SBAR(); GAPA(C0=__builtin_amdgcn_mfma_f32_32x32x16_bf16(kf[4],qr[2],C0,0,0,0),   P1[2],P1[3],P1[4],P1[5],     pw2[0]=PKW(P1,0), pw2[1]=PKW(P1,2), pw2); \
    VRD(6); SBAR(); GAPA(C1=__builtin_amdgcn_mfma_f32_32x32x16_bf16(kf[5],qr[2],C1,0,0,0),   P1[6],P1[7],P1[8],P1[9],     pw2[2]=PKW(P1,4), pw2[3]=PKW(P1,6), pw2); \
    VRD(3); SBAR(); GAPA(C0=__builtin_amdgcn_mfma_f32_32x32x16_bf16(kf[6],qr[3],C0,0,0,0),   P1[10],P1[11],P1[12],P1[13], pw3[0]=PKW(P1,8), pw3[1]=PKW(P1,10), pw3); \
    VRD(7); SBAR(); GAPA(C1=__builtin_amdgcn_mfma_f32_32x32x16_bf16(kf[7],qr[3],C1,0,0,0),   P1[14],P1[15],0.f,0.f,       pw3[2]=PKW(P1,12),pw3[3]=PKW(P1,14), pw3); \
    l_reg+=sacc; \
    if(GK){DMA_K((t)+3,sl_cur);} if(GV){DMA_V((t)+1,sl_next);} \
    CMASK(C0,C1,t); \
    { float a=MX3(C0[0],C0[1],C1[0]),b=MX3(C0[2],C0[3],C1[1]); a=MX3(a,C1[2],C1[3]); \
      _Pragma("unroll") for(int r=4;r<16;r+=4){a=MX3(a,C0[r],C0[r+1]);b=MX3(b,C0[r+2],C0[r+3]);a=MX3(a,C1[r],C1[r+1]);b=MX3(b,C1[r+2],C1[r+3]);} \
      float rm=__builtin_fmaxf(a,b); { auto rr=__builtin_amdgcn_permlane32_swap(__float_as_uint(rm),__float_as_uint(rm),false,false); rm=__builtin_fmaxf(__uint_as_float(rr[0]),__uint_as_float(rr[1])); } \
      resc=false; \
      if(__builtin_expect(__any(rm>(float)THRL),0)){ const float dl=__builtin_fmaxf(rm,0.f); mhat+=dl; \
        _Pragma("unroll") for(int r=0;r<16;++r){C0[r]-=dl;C1[r]-=dl;} \
        if constexpr(!MOBA){ _Pragma("unroll") for(int r=0;r<16;++r)negm[r]=-mhat; asm volatile("":"+v"(negm)); } \
        const float f=__builtin_amdgcn_exp2f(-dl); l_reg*=f; if(hi==0)wsf[r32]=f; resc=true; } } \
    SBAR(); \
    GAPB(o[0]=__builtin_amdgcn_mfma_f32_32x32x16_bf16(PAF(0),VFR(0),o[0],0,0,0), C0,0); \
    GAPB(o[1]=__builtin_amdgcn_mfma_f32_32x32x16_bf16(PAF(0),VFR(4),o[1],0,0,0), C0,4); \
    KRD(GL,0); GAPB(o[0]=__builtin_amdgcn_mfma_f32_32x32x16_bf16(PAF(1),VFR(1),o[0],0,0,0), C0,8); \
    KRD(GL,1); GAPB(o[1]=__builtin_amdgcn_mfma_f32_32x32x16_bf16(PAF(1),VFR(5),o[1],0,0,0), C0,12); \
    KRD(GL,2); GAPB(o[0]=__builtin_amdgcn_mfma_f32_32x32x16_bf16(PAF(2),VFR(2),o[0],0,0,0), C1,0); \
    KRD(GL,3); GAPB(o[1]=__builtin_amdgcn_mfma_f32_32x32x16_bf16(PAF(2),VFR(6),o[1],0,0,0), C1,4); \
    GAPB(o[0]=__builtin_amdgcn_mfma_f32_32x32x16_bf16(PAF(3),VFR(3),o[0],0,0,0), C1,8); \
    GAPB(o[1]=__builtin_amdgcn_mfma_f32_32x32x16_bf16(PAF(3),VFR(7),o[1],0,0,0), C1,12); \
    }while(0)
  int t=1;
  #undef CMASK
  #define CMASK(P0,P1,t) MBIAS(P0,P1,t,false)
  for(;t+5<NT;t+=2){
    STEP(pB0,pB1,pA0,pA1,t,true,true,true);     WAIT_BAR(2); RESC(); ROT();
    STEP(pA0,pA1,pB0,pB1,t+1,true,true,true);   WAIT_BAR(2); RESC(); ROT();
  }
  #undef CMASK
  #define CMASK(P0,P1,t) do{int jb_=(t)-(NT-4); MBIAS(P0,P1,t,jb_>=0); if(jb_>=0)cmask(P0,P1,jb_,qrel,hi);}while(0)
  #define ENDW(tt) do{ if((tt)+3<NT){WAIT_BAR(2);} else if((tt)+2<NT){WAIT_BAR(1);} else {WAIT_BAR(0);} }while(0)
  for(;t+1<NT;t+=2){
    STEP(pB0,pB1,pA0,pA1,t,(t+3<NT),(t+1<NT),(t+1<NT));       ENDW(t);   RESC(); ROT();
    STEP(pA0,pA1,pB0,pB1,t+1,(t+4<NT),(t+2<NT),(t+2<NT));     ENDW(t+1); RESC(); ROT();
  }
  STEP(pB0,pB1,pA0,pA1,NT-1,false,false,false); RESC();
  { float sacc=pB0[0]+pB0[1]; _Pragma("unroll") for(int r=2;r<16;++r)sacc+=pB0[r]; _Pragma("unroll") for(int r=0;r<16;++r)sacc+=pB1[r]; l_reg+=sacc;
    pw0=(u32x4){PKW(pB0,0),PKW(pB0,2),PKW(pB0,4),PKW(pB0,6)};pw1=(u32x4){PKW(pB0,8),PKW(pB0,10),PKW(pB0,12),PKW(pB0,14)};pw2=(u32x4){PKW(pB1,0),PKW(pB1,2),PKW(pB1,4),PKW(pB1,6)};pw3=(u32x4){PKW(pB1,8),PKW(pB1,10),PKW(pB1,12),PKW(pB1,14)};
    SBAR(); pv(o,vb0+sl_cur,PAF(0),PAF(1),PAF(2),PAF(3)); }
  #undef PKW
  #undef PAF
  #undef VFR
  #undef PIN
  #undef MX3
  #undef GAPA
  #undef GAPB
  #undef EX
  #undef VRD
  #undef KRD
  #undef STEP
  #undef ENDW
  {auto rr=__builtin_amdgcn_permlane32_swap(__float_as_uint(l_reg),__float_as_uint(l_reg),false,false);l_reg=__uint_as_float(rr[0])+__uint_as_float(rr[1]);}
  if(hi==0)wsf[32+r32]=l_reg;asm volatile("s_waitcnt lgkmcnt(0)":::"memory");
  float rli[16];
  #pragma unroll
  for(int r=0;r<16;++r)rli[r]=__builtin_amdgcn_rcpf(wsf[32+crow(r,hi)]);
  bf16*Ow=O+(rowbase+q0+wid*QBLK)*DMO+hv*D;
  { bf16*stg=(bf16*)(shm+LDS_OST)+wid*2048;
    #pragma unroll
    for(int r=0;r<16;++r){const int orow=crow(r,hi);
      #pragma unroll
      for(int d0=0;d0<2;++d0)stg[orow*64+d0*32+r32]=__float2bfloat16(o[d0][r]*rli[r]);}
    asm volatile("s_waitcnt lgkmcnt(0)":::"memory");
    #pragma unroll
    for(int i=0;i<4;++i){const int row=i*8+(lane>>3),ch=lane&7; const u32x4 v=*(const u32x4*)(stg+row*64+ch*8); ATTN_STORE16(Ow+(long)row*DMO+ch*8,v);} }
  asm volatile("s_waitcnt lgkmcnt(0)\n\ts_barrier":::"memory");
  #undef DMA_K
  #undef DMA_V
  #undef CMASK
  #undef START
  #undef RESC
  #undef ROT
  #undef MBIAS
}
__device__ __forceinline__ void glds16s(const void*sbase,unsigned voff,unsigned lds_dst){unsigned keep;
  asm volatile("s_mov_b32 %0, m0\n\ts_mov_b32 m0, %3\n\ts_nop 0\n\tglobal_load_lds_dwordx4 %1, %2\n\ts_mov_b32 m0, %0":"=&s"(keep):"v"(voff),"s"(sbase),"s"(lds_dst):"memory");}
constexpr int L2_K=0, L2_V=4*8192, L2_WS=L2_V+4*16384, L2_OST=L2_WS+2048, L2_BYTES=L2_OST+NW*4096;
template<int THRL,int DM,int EXPM=0> __device__ __forceinline__ void attn_unit2(int b,int hq,int hv,int qb,const bf16*Q,const bf16*__restrict__ K,const bf16*__restrict__ V,bf16*O,char*shm,int combine,const float*sg,const float*lamp,float oscale,int desc,const int wv_){
  int tid=(mk_lane()+((wv_)<<6)); asm volatile("":"+v"(tid));
  const int lane=tid&63,r32=lane&31,hi=lane>>5; const int wid=__builtin_amdgcn_readfirstlane(tid>>6);
  const long rowbase=(long)b*SEQ; const int q0=qb*QB;
  const bf16*Qw=Q+(rowbase+q0+wid*QBLK)*DM+hq*D;
  const bf16*Kh=K+rowbase*DM+hq*D,*Vh=V+rowbase*DM+hv*128;
  const unsigned lds0=(unsigned)(uintptr_t)shm;
  float*wsf=(float*)(shm+L2_WS)+wid*64;
  const bf16*ksb=Kh+wid*8; const unsigned kvo=(unsigned)lane*DM*2u;
  const bf16*vsb=Vh+(long)(16*(wid&3))*DM+(wid>>2)*32; const unsigned vvo=((unsigned)(lane>>2)*DM+(lane&3)*8)*2u;
  const unsigned kdst=lds0+L2_K+wid*1024, vdst=lds0+L2_V+wid*1024;
  #define DMAK(t,soff) if constexpr(!(EXPM&4)) glds16s(ksb+(long)(t)*KVBLK*DM,kvo,(unsigned)__builtin_amdgcn_readfirstlane(kdst+(soff)))
  #define DMAV(t,soff) do{ if constexpr(!(EXPM&4)){ glds16s(vsb+(long)(t)*KVBLK*DM,vvo,(unsigned)__builtin_amdgcn_readfirstlane(vdst+(soff))); } if constexpr(!(EXPM&4)) glds16s(vsb+(long)(t)*KVBLK*DM+64,vvo,(unsigned)__builtin_amdgcn_readfirstlane(vdst+(soff)+8192)); }while(0)
  const lds_cptr shm3=(lds_cptr)shm; const lds_cptr kp0=shm3+L2_K+hi*1024+r32*16; const lds_cptr vp0=shm3+L2_V+((lane>>4)&1)*32+(lane&3)*8+(4*hi+((lane&15)>>2))*64;
  const int NT=(q0+QB)/KVBLK;
  #define TI(j) (desc?NT-1-(j):(j))
  if(wid>=4) __builtin_amdgcn_s_setprio(1);
  DMAK(TI(0),0);
  bf16x8 qr[4];
  #pragma unroll
  for(int d0=0;d0<4;++d0)qr[d0]=*reinterpret_cast<const bf16x8*>(&Qw[(long)r32*DM+d0*16+hi*8]);
  asm volatile(""::"v"(qr[0]),"v"(qr[1]),"v"(qr[2]),"v"(qr[3]));
  DMAV(TI(0),0); DMAK(TI(1),8192); DMAV(TI(1),16384); DMAK(TI(2),16384);
  float mhat=0.f,l_reg=0.f; f32x16 o[4]; o[0]=f32x16{};o[1]=f32x16{};o[2]=f32x16{};o[3]=f32x16{};
  const f32x16 zero=f32x16{};
  bool resc=false;
  #define EX2(v) __builtin_amdgcn_exp2f(v)
  #define PIN2(x) asm volatile("":"+v"(x))
  #define MX3(a,b,c) __builtin_fmaxf(__builtin_fmaxf((a),(b)),(c))
  #define ROWMAX_FIN(a_,b_) do{ rm=__builtin_fmaxf(a_,b_); auto rr_=__builtin_amdgcn_permlane32_swap(__float_as_uint(rm),__float_as_uint(rm),false,false); rm=__builtin_fmaxf(__uint_as_float(rr_[0]),__uint_as_float(rr_[1])); }while(0)
  f32x16 pA0,pA1,pB0,pB1; float rm;
  WAIT_BAR(6);
  qkt(pA0,pA1,shm+L2_K,qr,zero,r32,hi);
  { const int jb0_=TI(0)-(NT-4); if(jb0_>=0) cmask(pA0,pA1,jb0_,wid*QBLK+r32,hi); }
  { float a_=MX3(pA0[0],pA0[1],pA1[0]),b_=MX3(pA0[2],pA0[3],pA1[1]); a_=MX3(a_,pA1[2],pA1[3]);
    #pragma unroll
    for(int r=4;r<16;r+=4){a_=MX3(a_,pA0[r],pA0[r+1]);b_=MX3(b_,pA0[r+2],pA0[r+3]);a_=MX3(a_,pA1[r],pA1[r+1]);b_=MX3(b_,pA1[r+2],pA1[r+3]);}
    ROWMAX_FIN(a_,b_); mhat=__builtin_fmaxf(rm,-64.f);
    #pragma unroll
    for(int r=0;r<16;++r){pA0[r]-=mhat;pA1[r]-=mhat;} }
  f32x16 negm;
  #pragma unroll
  for(int r=0;r<16;++r)negm[r]=-mhat;
  asm volatile("":"+v"(negm));
  const bool grpB=false;
  #define TOPBLK(tt) do{ if constexpr(!(EXPM&8)){ if((tt)+2<NT){ WAIT_BAR(3); } else if((tt)+1<NT){ WAIT_BAR(2); } else { WAIT_BAR(0); } } \
    if((tt)+2<NT){ DMAV(TI((tt)+2),(((tt)+2)&3)*16384); } if((tt)+3<NT){ DMAK(TI((tt)+3),(((tt)+3)&3)*8192); } }while(0)
  if(grpB) TOPBLK(0);
  #define EXP4(P,B) do{ if constexpr(!(EXPM&1)){ P[B]=EX2(P[B]); P[B+1]=EX2(P[B+1]); P[B+2]=EX2(P[B+2]); P[B+3]=EX2(P[B+3]); } }while(0)
  #define KL(i) if constexpr(!(EXPM&16)) kf[(i)&3]=*(const __attribute__((address_space(3))) bf16x8*)(kp0+kn+((i)>>1)*2048+((i)&1)*512)
  #define VOFFL(i) (((i)&1)*4096+((i)>>1)*1024)
  #define VRDL(i) do{ if constexpr(!(EXPM&16)){ vl[i]=vtr(vp_+VOFFL(i)); vh[i]=vtr(vp_+VOFFL(i)+512); } }while(0)
  #define VRDH(i) do{ if constexpr(!(EXPM&18)){ vl[i]=vtr(vp_+8192+VOFFL(i)); vh[i]=vtr(vp_+8192+VOFFL(i)+512); } }while(0)
  #define VFR2(i) (bf16x8){vl[i][0],vl[i][1],vl[i][2],vl[i][3],vh[i][0],vh[i][1],vh[i][2],vh[i][3]}
  #define PAF2(k) __builtin_bit_cast(bf16x8,pw[k])
  #define PKW2(P,B) cvtpk_s(P[B],P[B+1])
  #define G1(i,PNX,CIN,PC,PCB) do{ PNX=__builtin_amdgcn_mfma_f32_32x32x16_bf16(kf[(i)&3],qr[(i)>>1],CIN,0,0,0); if((i)<4){KL((i)+4);} VRDL(i); if((PCB)>=0){ EXP4(PC,((PCB)>=0?(PCB):0)); PIN2(PC); } SBAR(); }while(0)
  #define G2A(j,PC,PCB,HN,PN,PNB) do{ const bf16x8 vf_=VFR2(j); VRDH(j); o[(j)&1]=__builtin_amdgcn_mfma_f32_32x32x16_bf16(PAF2((j)>>1),vf_,o[(j)&1],0,0,0); \
      sacc+=PC[PCB]; sacc+=PC[PCB+1]; sacc+=PC[PCB+2]; sacc+=PC[PCB+3]; PIN2(sacc); \
      if(HN){ ma=MX3(ma,PN[PNB],PN[PNB+1]); ma=MX3(ma,PN[PNB+2],PN[PNB+3]); PIN2(ma); } SBAR(); }while(0)
  #define G2B(j) do{ if constexpr(!(EXPM&2)){ const bf16x8 vf_=VFR2(j); o[2+((j)&1)]=__builtin_amdgcn_mfma_f32_32x32x16_bf16(PAF2((j)>>1),vf_,o[2+((j)&1)],0,0,0); SBAR(); } }while(0)
  #define STEP2(PC0,PC1,PN0,PN1,t,HN) do{ \
    if(!grpB){ TOPBLK(t); }                         \
    const int kn=(((t)+1)&3)*8192, vc=((t)&3)*16384; \
    if(resc){ const float*wp_=(const float*)(shm+L2_WS)+wid*64+4*(mk_lane()>>5); _Pragma("unroll") for(int r=0;r<16;++r){ const float f_=wp_[(r&3)+8*(r>>2)]; o[0][r]*=f_; o[1][r]*=f_; o[2][r]*=f_; o[3][r]*=f_; } } \
    bf16x8 kf[4]; const lds_cptr vp_=vp0+vc; s16x4 vl[8],vh[8]; \
    if(HN){ KL(0); KL(1); KL(2); KL(3); } \
    SBAR(); \
    if(HN){ \
      EXP4(PC0,0); EXP4(PC0,4); PIN2(PC0); SBAR();                    \
      G1(0,PN0,negm,PC0,8); G1(1,PN1,negm,PC0,12); G1(2,PN0,PN0,PC1,0); G1(3,PN1,PN1,PC1,4); \
      G1(4,PN0,PN0,PC1,8);  G1(5,PN1,PN1,PC1,12);  G1(6,PN0,PN0,PC1,-1); G1(7,PN1,PN1,PC1,-1); \
    } else { VRDL(0); VRDL(1); VRDL(2); VRDL(3); VRDL(4); VRDL(5); VRDL(6); VRDL(7); \
      EXP4(PC0,0); EXP4(PC0,4); EXP4(PC0,8); EXP4(PC0,12); EXP4(PC1,0); EXP4(PC1,4); EXP4(PC1,8); EXP4(PC1,12); } \
    u32x4 pw[4]; pw[0]=(u32x4){PKW2(PC0,0),PKW2(PC0,2),PKW2(PC0,4),PKW2(PC0,6)}; pw[1]=(u32x4){PKW2(PC0,8),PKW2(PC0,10),PKW2(PC0,12),PKW2(PC0,14)}; \
    pw[2]=(u32x4){PKW2(PC1,0),PKW2(PC1,2),PKW2(PC1,4),PKW2(PC1,6)}; pw[3]=(u32x4){PKW2(PC1,8),PKW2(PC1,10),PKW2(PC1,12),PKW2(PC1,14)}; \
    if(HN){ const int jb_=TI((t)+1)-(NT-4); if(jb_>=0){ const int ln_=mk_lane(); cmask(PN0,PN1,jb_,wid*QBLK+(ln_&31),ln_>>5); } } \
    if(grpB){ if((t)+1<NT){ TOPBLK((t)+1); } else { if constexpr(!(EXPM&8)){ WAIT_BAR(0); } } } \
    float sacc=0.f,ma=-INFINITY; SBAR(); \
    G2A(0,PC0,0,HN,PN0,0);  G2A(1,PC0,4,HN,PN0,4);  G2A(2,PC0,8,HN,PN0,8);   G2A(3,PC0,12,HN,PN0,12); \
    G2A(4,PC1,0,HN,PN1,0);  G2A(5,PC1,4,HN,PN1,4);  G2A(6,PC1,8,HN,PN1,8);   G2A(7,PC1,12,HN,PN1,12); \
    G2B(0); G2B(1); G2B(2); G2B(3); G2B(4); G2B(5); G2B(6); G2B(7); \
    l_reg+=sacc; resc=false; \
    if(HN){ ROWMAX_FIN(ma,ma); \
      if(__any(rm>(float)THRL)){ const float dl_=__builtin_fmaxf(rm,0.f); mhat+=dl_; _Pragma("unroll") for(int r=0;r<16;++r){PN0[r]-=dl_;PN1[r]-=dl_;} _Pragma("unroll") for(int r=0;r<16;++r)negm[r]=-mhat; asm volatile("":"+v"(negm)); \
        const float f_=EX2(-dl_); l_reg*=f_; { const int ln_=mk_lane(); if(ln_<32)((float*)(shm+L2_WS))[wid*64+ln_]=f_; } resc=true; } } \
  }while(0)
  int t=0;
  #pragma unroll 1
  for(;t+2<NT;t+=2){
    STEP2(pA0,pA1,pB0,pB1,t,true);
    STEP2(pB0,pB1,pA0,pA1,t+1,true);
  }
  STEP2(pA0,pA1,pB0,pB1,NT-2,true);
  STEP2(pB0,pB1,pA0,pA1,NT-1,false);
  if(!grpB){ if constexpr(!(EXPM&8)){ WAIT_BAR(0); } }
  #undef STEP2
  #undef TI
  #undef TOPBLK
  #undef G1
  #undef G2A
  #undef G2B
  #undef KL
  #undef VRDL
  #undef VRDH
  #undef VOFFL
  #undef PKW2
  #undef PAF2
  #undef VFR2
  #undef EXP4
  #undef ROWMAX_FIN
  #undef MX3
  #undef EX2
  #undef PIN2
  #undef DMAK
  #undef DMAV
  __builtin_amdgcn_s_setprio(0);
  {
    int tid2=(mk_lane()+((wv_)<<6)); asm volatile("":"+v"(tid2));
    const int lane_e=tid2&63,r32e=lane_e&31,hie=lane_e>>5;
    float*wsfe=(float*)(shm+L2_WS)+wid*64;
    {auto rr=__builtin_amdgcn_permlane32_swap(__float_as_uint(l_reg),__float_as_uint(l_reg),false,false);l_reg=__uint_as_float(rr[0])+__uint_as_float(rr[1]);}
    if(hie==0)wsfe[32+r32e]=l_reg;asm volatile("s_waitcnt lgkmcnt(0)":::"memory");
    float rli[16];
    #pragma unroll
    for(int r=0;r<16;++r)rli[r]=__builtin_amdgcn_rcpf(wsfe[32+crow(r,hie)]);
    bf16*Ow=O+((long)b*SEQ+qb*QB+wid*QBLK)*DM+hv*128;
    bf16*stg=(bf16*)(shm+L2_OST)+wid*2048;
    if(!combine){
      #pragma unroll
      for(int hf=0;hf<2;++hf){
        #pragma unroll
        for(int r=0;r<16;++r){const int orow=crow(r,hie);
          #pragma unroll
          for(int d0=0;d0<2;++d0)stg[orow*64+d0*32+r32e]=__float2bfloat16(o[2*hf+d0][r]*rli[r]);}
        asm volatile("s_waitcnt lgkmcnt(0)":::"memory");
        #pragma unroll
        for(int i=0;i<4;++i){const int row=i*8+(lane_e>>3),ch=lane_e&7; const u32x4 v=*(const u32x4*)(stg+row*64+ch*8); ATTN_STORE16(Ow+(long)row*DM+hf*64+ch*8,v);}
        asm volatile("s_waitcnt lgkmcnt(0)":::"memory"); }
    } else {
      const float lam2=*lamp; const float osc2=oscale;
      u32x4 o0c[2][4];
      #pragma unroll
      for(int hf=0;hf<2;++hf)
        #pragma unroll
        for(int i=0;i<4;++i) o0c[hf][i]=*(const u32x4*)(Ow+(long)(i*8+(lane_e>>3))*DM+hf*64+(lane_e&7)*8);
      float dd[2][4][8]; float ssq[4]={0.f,0.f,0.f,0.f};
      #pragma unroll
      for(int hf=0;hf<2;++hf){
        #pragma unroll
        for(int r=0;r<16;++r){const int orow=crow(r,hie);
          #pragma unroll
          for(int d0=0;d0<2;++d0)stg[orow*64+d0*32+r32e]=__float2bfloat16(o[2*hf+d0][r]*rli[r]);}
        asm volatile("s_waitcnt lgkmcnt(0)":::"memory");
        #pragma unroll
        for(int i=0;i<4;++i){const int row=i*8+(lane_e>>3),ch=lane_e&7; const u32x4 v=*(const u32x4*)(stg+row*64+ch*8);
          #pragma unroll
          for(int e=0;e<4;++e){ const float a0=__uint_as_float(o0c[hf][i][e]<<16),a1=__uint_as_float(o0c[hf][i][e]&0xffff0000u),b0=__uint_as_float(v[e]<<16),b1=__uint_as_float(v[e]&0xffff0000u);
            const float x0=a0-lam2*b0,x1=a1-lam2*b1; dd[hf][i][2*e]=x0; dd[hf][i][2*e+1]=x1; ssq[i]+=x0*x0+x1*x1; } }
        asm volatile("s_waitcnt lgkmcnt(0)":::"memory"); }
      #pragma unroll
      for(int i=0;i<4;++i){ float q=ssq[i];
        q+=__uint_as_float(__builtin_amdgcn_update_dpp(0u,__float_as_uint(q),0xB1,0xF,0xF,true)); q+=__uint_as_float(__builtin_amdgcn_update_dpp(0u,__float_as_uint(q),0x4E,0xF,0xF,true)); q+=__uint_as_float(__builtin_amdgcn_update_dpp(0u,__float_as_uint(q),0x141,0xF,0xF,true));
        ssq[i]=osc2*__builtin_amdgcn_rsqf(q*(1.0f/128.0f)+1e-6f); }
      #pragma unroll
      for(int hf=0;hf<2;++hf){ const float*gp=sg+hf*64+(lane_e&7)*8; const f32x4m g0=*reinterpret_cast<const f32x4m*>(gp), g1=*reinterpret_cast<const f32x4m*>(gp+4);
        #pragma unroll
        for(int i=0;i<4;++i){ const int row=i*8+(lane_e>>3),ch=lane_e&7; const float rr_=ssq[i]; u32x4 w;
          w[0]=cvtpk_s(dd[hf][i][0]*rr_*g0[0],dd[hf][i][1]*rr_*g0[1]); w[1]=cvtpk_s(dd[hf][i][2]*rr_*g0[2],dd[hf][i][3]*rr_*g0[3]);
          w[2]=cvtpk_s(dd[hf][i][4]*rr_*g1[0],dd[hf][i][5]*rr_*g1[1]); w[3]=cvtpk_s(dd[hf][i][6]*rr_*g1[2],dd[hf][i][7]*rr_*g1[3]);
          ATTN_STORE16(Ow+(long)row*DM+hf*64+ch*8,w); } }
    } }
}

#undef SBAR
#undef WAIT_BAR
}


namespace cg = cooperative_groups;
#define LAS __attribute__((address_space(3)))
typedef unsigned short u16;
typedef unsigned v4u __attribute__((ext_vector_type(4)));
typedef unsigned v2u __attribute__((ext_vector_type(2)));
typedef float f32x4 __attribute__((ext_vector_type(4)));
typedef float f32x16 __attribute__((ext_vector_type(16)));
typedef short bf16x8 __attribute__((ext_vector_type(8)));

#define RLX_AGENT __ATOMIC_RELAXED, __HIP_MEMORY_SCOPE_AGENT
#define XB_TMO      128
#define XB_XCNT(j)  (256  + 64 * (j))
#define XB_XSUB(j)  (1280 + 64 * (j))
#define XB_XGEN(j)  (2304 + 64 * (j))
#define XB_TOP      3328
#define XB_TOPGEN   3392
#define XCD_BAR_WORDS 3456
#define XB_SPIN_CAP (1u << 18)

__device__ __forceinline__ unsigned xb_ld(unsigned* p)              { return __hip_atomic_load(p, __ATOMIC_RELAXED, __HIP_MEMORY_SCOPE_AGENT); }
__device__ __forceinline__ unsigned xb_add(unsigned* p, unsigned v) { return __hip_atomic_fetch_add(p, v, __ATOMIC_RELAXED, __HIP_MEMORY_SCOPE_AGENT); }
__device__ __forceinline__ unsigned xb_xcc_id() { return (unsigned)__builtin_amdgcn_s_getreg((3 << 11) | 20) & 0xFu; }
#define XB_SPIN(cond, bar) do { unsigned _sp = 0; while (cond) { __builtin_amdgcn_s_sleep(1); \
    if ((++_sp & 255u) == 0u) { if (xb_ld(&(bar)[XB_TMO])) break; if (_sp > XB_SPIN_CAP) { atomicAdd(&(bar)[XB_TMO], 1u); break; } } } } while (0)

struct XcdBarrier {
    unsigned* bar; unsigned x;
    volatile LAS unsigned* st;
};

__device__ __forceinline__ XcdBarrier xcd_barrier_post(unsigned* bar, volatile LAS unsigned* st, const int wv_) {
    XcdBarrier b; b.bar = bar; b.x = xb_xcc_id(); b.st = st;
    if ((mk_lane()+((wv_)<<6)) == 0) (void)xb_add(&bar[XB_XCNT(b.x)], 1u);
    return b;
}
__device__ __forceinline__ void xcd_barrier_complete(unsigned* bar, unsigned x, unsigned& nloc, unsigned& nx) {
    const unsigned G = gridDim.x * gridDim.y * gridDim.z;
    unsigned sum, cnt, mine, sp = 0u;
    for (;;) {
        sum = 0u; cnt = 0u; mine = 0u;
#pragma unroll
        for (unsigned j = 0; j < 16; ++j) { const unsigned c = xb_ld(&bar[XB_XCNT(j)]); sum += c; cnt += (c > 0u) ? 1u : 0u; mine = (j == x) ? c : mine; }
        if (sum == G) break;
        __builtin_amdgcn_s_sleep(1);
        if ((++sp & 255u) == 0u) { if (xb_ld(&bar[XB_TMO])) break; if (sp > XB_SPIN_CAP) { atomicAdd(&bar[XB_TMO], 1u); break; } }
    }
    nloc = mine > 0u ? mine : 1u; nx = cnt > 0u ? cnt : 1u;
}

__device__ __forceinline__ void xcd_barrier(const XcdBarrier& b, const int wv_) {
    asm volatile("s_waitcnt vmcnt(0)" ::: "memory");
    __syncthreads();
    if ((mk_lane()+((wv_)<<6)) == 0) {
        unsigned* bar = b.bar;
        __builtin_amdgcn_s_waitcnt(0);
        unsigned nloc = b.st[0], nx = b.st[1];
        if (nloc == 0u) { xcd_barrier_complete(bar, b.x, nloc, nx); b.st[0] = nloc; b.st[1] = nx; }
        const unsigned old = xb_add(&bar[XB_XSUB(b.x)], 1u);
        const unsigned gen = old / nloc;
        if (old + 1u == (gen + 1u) * nloc) {
            __builtin_amdgcn_fence(__ATOMIC_RELEASE, "agent");
            asm volatile("s_waitcnt vmcnt(0)" ::: "memory");
            const unsigned og = xb_add(&bar[XB_TOP], 1u);
            const unsigned tg = og / nx;
            if (og + 1u == (tg + 1u) * nx) xb_add(&bar[XB_TOPGEN], 1u);
            else XB_SPIN(xb_ld(&bar[XB_TOPGEN]) == tg, bar);
            __builtin_amdgcn_fence(__ATOMIC_ACQUIRE, "agent");
            xb_add(&bar[XB_XGEN(b.x)], 1u);
            asm volatile("s_waitcnt vmcnt(0)" ::: "memory");
        } else {
            XB_SPIN(xb_ld(&bar[XB_XGEN(b.x)]) == gen, bar);
            __builtin_amdgcn_fence(__ATOMIC_ACQUIRE, "agent");
            asm volatile("s_waitcnt vmcnt(0)" ::: "memory");
        }
    }
    __syncthreads();
}

constexpr int NWAVES = 8;
constexpr int BATCH = 4, SEQ = 8192, DMODEL = 1024, FF = 2816, M = BATCH * SEQ;
constexpr int LDS_BYTES = 147456;
constexpr size_t MiB = 1u << 20;
constexpr size_t WS_ROPE = 0;
constexpr size_t WS_KMEAN = 1 * MiB;
constexpr size_t WS_SS = 2 * MiB;
constexpr size_t WS_LAM = 6 * MiB;
constexpr size_t WS_BAR = 5 * MiB;
constexpr size_t WS_RDY = 5 * MiB + 64 * 1024;
constexpr unsigned BAR_MAGIC = 0x5eed1234u;
constexpr size_t WS_WSB = 4 * MiB;
constexpr size_t WS_W = 8 * MiB;
constexpr size_t WS_XB = 96 * MiB;
constexpr size_t WS_H = 160 * MiB;
constexpr size_t WS_EQ = 160 * MiB;
constexpr size_t WS_EY = 336 * MiB;
constexpr size_t WS_OQ = 160 * MiB;
constexpr size_t WS_O0 = 352 * MiB, WS_O1 = 416 * MiB;
constexpr size_t WS_END = 480 * MiB;
constexpr size_t W_GU = 0, W_GU_SZ = (size_t)2 * FF * DMODEL, W_DN = 4 * W_GU_SZ, W_DN_SZ = (size_t)FF * DMODEL;
constexpr size_t W_EIN = W_DN + 4 * W_DN_SZ, W_EOUT = W_EIN + (size_t)2560 * 1024, W_OIN = W_EOUT + (size_t)1024 * 1024, W_OOUT = W_OIN + (size_t)3072 * 1024, W_ENDE = W_OOUT + (size_t)1024 * 1024;
static_assert(WS_W + W_ENDE * 2 <= WS_XB, "weights fit");
constexpr float C2Q = 0.125f * 1.4426950408889634f;

__device__ __forceinline__ float wave_sum(float v) {
#pragma unroll
    for (int o = 1; o < 64; o <<= 1) v += __shfl_xor(v, o);
    return v;
}
__device__ __forceinline__ unsigned f2bf(float f) { unsigned u = __builtin_bit_cast(unsigned, f); return (u + 0x7fffu + ((u >> 16) & 1u)) >> 16; }
__device__ __forceinline__ unsigned pk2(float lo, float hi) { return f2bf(lo) | (f2bf(hi) << 16); }
__device__ __forceinline__ float bf2f(unsigned h) { return __builtin_bit_cast(float, h << 16); }
__device__ __forceinline__ int dimof(int p) { return p < 16 ? ((p & 1) ? (p >> 1) + 8 : (p >> 1)) : p; }

__device__ __forceinline__ int physof(int d) { return d < 8 ? 2 * d : (d < 16 ? 2 * (d - 8) + 1 : d); }
__device__ __forceinline__ void tr_item(const float* W, int K, int Nsrc, int scol0, bool perm, const float* gain, u16* WT, int n0dst, int k0, LAS float* scr, int lane) {
    const int rr = lane >> 3, c4 = (lane & 7) * 4;
    f32x4 w[8];
#pragma unroll
    for (int i = 0; i < 8; ++i) w[i] = *(const f32x4*)(W + (size_t)(k0 + 8 * i + rr) * Nsrc + scol0 + c4);
    int dp[4];
#pragma unroll
    for (int j = 0; j < 4; ++j) dp[j] = perm ? physof(c4 + j) : (c4 + j);
#pragma unroll
    for (int i = 0; i < 8; ++i) { const int kk = 8 * i + rr; const float g = gain ? gain[k0 + kk] : 1.0f;
#pragma unroll
        for (int j = 0; j < 4; ++j) scr[kk * 33 + dp[j]] = w[i][j] * g; }
    asm volatile("s_waitcnt lgkmcnt(0)" ::: "memory");
    const int c = lane & 7;
#pragma unroll
    for (int j = 0; j < 4; ++j) { const int n = (lane >> 3) + 8 * j; const LAS float* s = scr + (8 * c) * 33 + n;
        v4u o; o.x = pk2(s[0 * 33], s[1 * 33]); o.y = pk2(s[2 * 33], s[3 * 33]); o.z = pk2(s[4 * 33], s[5 * 33]); o.w = pk2(s[6 * 33], s[7 * 33]);
        *(v4u*)(WT + (size_t)(n0dst + n) * K + k0 + 8 * c) = o; }
    asm volatile("s_waitcnt lgkmcnt(0)" ::: "memory");
}

#ifndef PHASES
#define PHASES 0xff
#endif
#define PHON(k) (((PHASES) >> (k)) & 1)
#ifndef NOATT
#define NOATT 0
#endif
#ifndef NOGMLP
#define NOGMLP 0
#endif
struct Args { const float* in[24]; float* out; unsigned char* ws; };

__device__ __forceinline__ void gmlp_unit(int chunk, int g, int lane, LAS unsigned char* wl, const u16* U, const u16* Vg, const float* lng, const float* lnb, const u16* Wsb, const float* bs, u16* Y) {
    const int row0 = chunk * 128, r32 = lane & 31, hi = lane >> 5;
    LAS u16* vT = (LAS u16*)wl;
#pragma unroll 1
    for (int rr = 0; rr < 2; ++rr) { const int s = lane + 64 * rr; const v4u* vp = (const v4u*)(Vg + (size_t)(row0 + s) * 512 + g * 64);
        float v[64];
#pragma unroll
        for (int c = 0; c < 8; ++c) { const v4u w = vp[c];
#pragma unroll
            for (int e = 0; e < 4; ++e) { v[c * 8 + 2 * e] = bf2f(w[e] & 0xffffu); v[c * 8 + 2 * e + 1] = bf2f(w[e] >> 16); } }
        float sum = 0.f;
#pragma unroll
        for (int d = 0; d < 64; ++d) sum += v[d];
        const float mean = sum * (1.0f / 64.0f); float var = 0.f;
#pragma unroll
        for (int d = 0; d < 64; ++d) { v[d] -= mean; var += v[d] * v[d]; }
        const float rstd = 1.0f / sqrtf(var * (1.0f / 64.0f) + 1e-6f);
#pragma unroll
        for (int d = 0; d < 64; ++d) { const float y = v[d] * rstd * lng[g * 64 + d] + lnb[g * 64 + d]; vT[d * 136 + s] = (u16)f2bf(y); }
    }
    asm volatile("s_waitcnt lgkmcnt(0)" ::: "memory");
    const u16* Wg = Wsb + (size_t)g * 16384;
    f32x16 acc[4][2];
#pragma unroll
    for (int ti = 0; ti < 4; ++ti)
#pragma unroll
        for (int di = 0; di < 2; ++di) { acc[ti][di] = f32x16{};
#pragma unroll
            for (int ks = 0; ks < 2 * ti + 2; ++ks) { const bf16x8 a = *(const bf16x8*)(Wg + (size_t)(32 * ti + r32) * 128 + 16 * ks + 8 * hi);
                const bf16x8 b = *(const LAS bf16x8*)(vT + (32 * di + r32) * 136 + 16 * ks + 8 * hi);
                acc[ti][di] = __builtin_amdgcn_mfma_f32_32x32x16_bf16(a, b, acc[ti][di], 0, 0, 0); }
            __builtin_amdgcn_sched_barrier(0); }
    asm volatile("s_waitcnt lgkmcnt(0)" ::: "memory");
    LAS u16* mx = (LAS u16*)wl;
    LAS u16* mb = mx + (4 * hi) * 64 + r32;
#pragma unroll
    for (int ti = 0; ti < 4; ++ti)
#pragma unroll
        for (int di = 0; di < 2; ++di)
#pragma unroll
            for (int r = 0; r < 16; ++r) mb[(32 * ti + (r & 3) + 8 * (r >> 2)) * 64 + 32 * di] = (u16)f2bf(acc[ti][di][r]);
    v4u uc[16];
#pragma unroll
    for (int i = 0; i < 16; ++i) { const int id = i * 64 + lane; uc[i] = *(const v4u*)(U + (size_t)(row0 + (id >> 3)) * 512 + g * 64 + (id & 7) * 8); }
    asm volatile("s_waitcnt lgkmcnt(0)" ::: "memory");
#pragma unroll
    for (int i = 0; i < 16; ++i) { const int id = i * 64 + lane, t = id >> 3, ch = id & 7; const v4u mv = *(const LAS v4u*)(mx + t * 64 + ch * 8); const float bsv = bs[g * 128 + t]; v4u o;
#pragma unroll
        for (int e = 0; e < 4; ++e) o[e] = pk2(bf2f(uc[i][e] & 0xffffu) * (bf2f(mv[e] & 0xffffu) + bsv), bf2f(uc[i][e] >> 16) * (bf2f(mv[e] >> 16) + bsv));
        *(v4u*)(Y + (size_t)(row0 + t) * 1024 + 512 + g * 64 + ch * 8) = o; }
    asm volatile("s_waitcnt lgkmcnt(0)" ::: "memory");
}

template <int step> __device__ __forceinline__ void do_step(const Args& args, unsigned char* lds, const int wv_) {
    LAS unsigned char* ldsl = (LAS unsigned char*)lds;
    int tid_ = (mk_lane()+((wv_)<<6)); asm volatile("" : "+v"(tid_));
    const int tid = tid_, lane = tid & 63, wave = __builtin_amdgcn_readfirstlane(tid >> 6);
    const int G = gridDim.x, bx = blockIdx.x;
    const int vcu = (G % 8 == 0) ? (bx % 8) * (G / 8) + bx / 8 : bx;
    const int gw = vcu * NWAVES + wave, NGW = G * NWAVES;
    unsigned char* ws = args.ws;
    float* rope = (float*)(ws + WS_ROPE); float* kmean = (float*)(ws + WS_KMEAN); float* ss = (float*)(ws + WS_SS);
    u16* Wsb = (u16*)(ws + WS_WSB); u16* Wc = (u16*)(ws + WS_W); u16* XB = (u16*)(ws + WS_XB); u16* HB = (u16*)(ws + WS_H);
    float* out = args.out;
    (void)rope; (void)kmean; (void)ss; (void)Wsb; (void)Wc; (void)XB; (void)HB; (void)out; (void)gw; (void)NGW; (void)lane; (void)ldsl;
        if constexpr (PHON(0) && step == 0) {
            LAS float* scr = (LAS float*)(ldsl + wave * 16384);
            constexpr int I_GU = 16 * 176, I_DN = 44 * 32, I_EIN = 16 * 80, I_OUT = 16 * 32, I_OIN = 16 * 96;
            constexpr int NITEMS = 4 * I_GU + 4 * I_DN + I_EIN + I_OUT + I_OIN + I_OUT;
#ifndef P0REP_T
#define P0REP_T 1
#endif
#ifndef P0REP_X
#define P0REP_X 1
#endif
            for (int rep_t = 0; rep_t < P0REP_T; ++rep_t)
            for (int it = gw; it < NITEMS; it += NGW) {
                int r = it;
                if (r < 4 * I_GU) { const int f = r / I_GU; r -= f * I_GU; const int l = f >> 1, post = f & 1;
                    const int kb = r / 176, nb = r % 176, n0 = 32 * nb, c = n0 & 255, j0 = 128 * (n0 >> 8) + (c & 127);
                    const float* Wsrc = args.in[(post ? 7 : 2) + (c >= 128 ? 1 : 0)] + (size_t)l * 1024 * FF;
                    const float* gain = args.in[post ? 6 : 1] + l * 1024;
                    tr_item(Wsrc, 1024, FF, j0, false, gain, Wc + W_GU + (size_t)f * W_GU_SZ, n0, 64 * kb, scr, lane); continue; }
                r -= 4 * I_GU;
                if (r < 4 * I_DN) { const int f = r / I_DN; r -= f * I_DN; const int l = f >> 1, post = f & 1; const int kb = r / 32, nb = r % 32;
                    tr_item(args.in[post ? 9 : 4] + (size_t)l * FF * 1024, FF, 1024, 32 * nb, false, nullptr, Wc + W_DN + (size_t)f * W_DN_SZ, 32 * nb, 64 * kb, scr, lane); continue; }
                r -= 4 * I_DN;
                if (r < I_EIN) { const int kb = r / 80, nb = r % 80, n0 = 32 * nb;
                    tr_item(args.in[10], 1024, 2560, n0, (n0 < 1024) && ((n0 & 63) == 0), args.in[5], Wc + W_EIN, n0, 64 * kb, scr, lane); continue; }
                r -= I_EIN;
                if (r < I_OUT) { const int kb = r / 32, nb = r % 32; tr_item(args.in[11], 1024, 1024, 32 * nb, false, nullptr, Wc + W_EOUT, 32 * nb, 64 * kb, scr, lane); continue; }
                r -= I_OUT;
                if (r < I_OIN) { const int kb = r / 96, nb = r % 96, n0 = 32 * nb;
                    tr_item(args.in[16], 1024, 3072, n0, (n0 < 2048) && ((n0 & 63) == 0), args.in[5] + 1024, Wc + W_OIN, n0, 64 * kb, scr, lane); continue; }
                r -= I_OIN;
                { const int kb = r / 32, nb = r % 32; tr_item(args.in[17], 1024, 1024, 32 * nb, false, nullptr, Wc + W_OOUT, 32 * nb, 64 * kb, scr, lane); }
            }
            const int gt = vcu * 512 + tid, NGT = G * 512;
            for (int i = gt; i < 8192 * 8; i += NGT) { const int pos = i >> 3, k = i & 7;
                const float inv = 1.0f / powf(500000.0f, (float)(2 * k) / 16.0f); const float ang = (float)pos * inv;
                double t = (double)ang * 0.15915494309189535; t -= floor(t); const float fr = (float)t;
                rope[2 * i] = __builtin_amdgcn_cosf(fr); rope[2 * i + 1] = __builtin_amdgcn_sinf(fr); }
            for (int i = gt; i < BATCH * 32 * 512; i += NGT) kmean[i] = 0.f;
            if (gw == 0) { const float s1 = wave_sum(args.in[18][lane] * args.in[19][lane]), s2 = wave_sum(args.in[20][lane] * args.in[21][lane]);
                if (lane == 0) *(float*)(ws + WS_LAM) = expf(s1) - expf(s2) + 0.35550906759096927f; }
            for (int i = gt; i < 8 * 128 * 128; i += NGT) { const int t = (i >> 7) & 127, s = i & 127; Wsb[i] = (u16)f2bf(s <= t ? args.in[14][i] : 0.f); }
            const float* x = args.in[0];
            for (int rep_x = 0; rep_x < P0REP_X; ++rep_x)
            for (int m0 = 2 * gw; m0 < M; m0 += 2 * NGW) { f32x4 v[2][4];
#pragma unroll
                for (int q = 0; q < 2; ++q) { const f32x4* xr = (const f32x4*)(x + (size_t)(m0 + q) * 1024) + lane;
#pragma unroll
                    for (int j = 0; j < 4; ++j) v[q][j] = xr[64 * j]; }
#pragma unroll
                for (int q = 0; q < 2; ++q) { const int m = m0 + q; float s = 0.f;
#pragma unroll
                    for (int j = 0; j < 4; ++j) s += (v[q][j][0] * v[q][j][0] + v[q][j][1] * v[q][j][1]) + (v[q][j][2] * v[q][j][2] + v[q][j][3] * v[q][j][3]);
                    s = wave_sum(s);
                    v2u* o8 = (v2u*)(XB + (size_t)m * 1024) + lane;
#pragma unroll
                    for (int j = 0; j < 4; ++j) { v2u w; w.x = pk2(v[q][j][0], v[q][j][1]); w.y = pk2(v[q][j][2], v[q][j][3]); o8[64 * j] = w; }
                    if (lane < 16) ss[(size_t)m * 16 + lane] = (lane == 0) ? s : 0.f; } }
        } else if constexpr (PHON(1) && (step == 1 || step == 6 || step == 8 || step == 14)) {
            const int f = (step == 1) ? 0 : (step == 6) ? 1 : (step == 8) ? 2 : 3;
            pg8::Gemm g{XB, Wc + W_GU + (size_t)f * W_GU_SZ, M, 2 * FF, 1024}; pg8::StaticOrder S; S.init(M, 2 * FF, G, bx);
            pg8::EpiSwiglu E{HB, FF, ss};
            pg8::gemm_phase<pg8::EpiSwiglu, pg8::StaticOrder, true, true>(ldsl, g, S, E, wv_);
        } else if constexpr (PHON(2) && (step == 2 || step == 5 || step == 7 || step == 9 || step == 13 || step == 15)) {
            const u16* A; const u16* Bt; int K; float alpha = 0.5f;
            if (step == 2) { A = HB; Bt = Wc + W_DN; K = FF; }
            else if (step == 5) { A = (const u16*)(ws + WS_EY); Bt = Wc + W_EOUT; K = 1024; alpha = 1.0f; }
            else if (step == 7) { A = HB; Bt = Wc + W_DN + W_DN_SZ; K = FF; }
            else if (step == 9) { A = HB; Bt = Wc + W_DN + 2 * W_DN_SZ; K = FF; }
            else if (step == 13) { A = (const u16*)(ws + WS_O0); Bt = Wc + W_OOUT; K = 1024; alpha = 1.0f; }
            else { A = HB; Bt = Wc + W_DN + 3 * W_DN_SZ; K = FF; }
            pg8::Gemm g{A, Bt, M, 1024, K}; pg8::StaticOrder S; S.init(M, 1024, G, bx);
            pg8::EpiResid E{XB, ss, alpha};
            pg8::gemm_phase<pg8::EpiResid, pg8::StaticOrder, true, true>(ldsl, g, S, E, wv_);
        } else if constexpr (PHON(3) && (step == 3 || step == 10)) {
            const bool even = (step == 3); const int N = even ? 2560 : 3072;
            pg8::Gemm g{XB, Wc + (even ? W_EIN : W_OIN), M, N, 1024}; pg8::StaticOrder S; S.init(M, N, G, bx);
            pg8::EpiIn E{(u16*)(ws + (even ? WS_EQ : WS_OQ)), even ? (size_t)M * 512 : (size_t)M * 1024, even ? 2 : 4, ss, rope, even ? kmean : nullptr, C2Q};
            pg8::gemm_phase<pg8::EpiIn, pg8::StaticOrder, true, true>(ldsl, g, S, E, wv_);
        } else if constexpr (PHON(4) && step == 4) {
            const attn_body::bf16* Qe = (const attn_body::bf16*)(ws + WS_EQ); const attn_body::bf16* Ke = Qe + (size_t)M * 512; const attn_body::bf16* Ve = Ke + (size_t)M * 512;
            const u16* Ue = (const u16*)(ws + WS_EQ) + (size_t)3 * M * 512; const u16* Vge = Ue + (size_t)M * 512;
            u16* Y = (u16*)(ws + WS_EY);
            if (!NOATT) for (int it = 0; it < 4; ++it) { const int qd = vcu + (it >> 2) * G; if (qd >= 256) break; const int i = it & 3;
                const int bh = qd >> 3, s = qd & 7;
                const int qb = (i == 0) ? s : (i == 1) ? 15 - s : (i == 2) ? 16 + s : 31 - s;
                attn_body::attn_unit<8, 512, 1024, true>(bh >> 3, bh & 7, bh & 7, qb, Qe, Ke, Ve, (attn_body::bf16*)Y, (char*)lds, kmean, wv_); }
            __syncthreads();
#ifndef GMLPREP
#define GMLPREP 1
#endif
            for (int rep_ = 0; rep_ < GMLPREP; ++rep_) for (int c = vcu; c < 256; c += G)
                gmlp_unit(c, wave, lane, ldsl + wave * 17408, Ue, Vge, args.in[12], args.in[13], Wsb, args.in[15], Y);
        } else if constexpr (PHON(5) && step == 11) {
            const attn_body::bf16* Qo = (const attn_body::bf16*)(ws + WS_OQ); const attn_body::bf16* Ko = Qo + (size_t)M * 1024; const attn_body::bf16* Vo = Ko + (size_t)M * 1024;
            constexpr float linit = 0.35550906759096927f;
            for (int it = 0; ; ++it) { int b, h, c, qb, desc;
                if (G == 256) { if (it >= 8) break; const int x = vcu >> 5, j = vcu & 31, k = j & 15, bh = x * 4 + (it >> 2) * 2 + (j >> 4), u = it & 3; h = bh & 7; b = bh >> 3; c = u >> 1; qb = (u == 0 || u == 3) ? k : 31 - k; desc = u & 1; }
                else { const int tq = vcu + (it >> 1) * G; if (tq >= 1024) break; c = it & 1; qb = tq & 31; const int bh = tq >> 5; h = bh & 7; b = bh >> 3; desc = 0; }
                attn_body::attn_unit2<8, 1024>(b, 2 * h + c, h, qb, Qo, Ko, Vo, (attn_body::bf16*)(ws + WS_O0), (char*)lds, c, args.in[22], (const float*)(ws + WS_LAM), 1.0f - linit, desc, wv_); }
        } else if constexpr (PHON(6) && step == 12) {
        } else if constexpr (PHON(7) && step == 16) {
            const float* fg = args.in[23];
            for (int m0 = 2 * gw; m0 < M; m0 += 2 * NGW) { v2u w[2][4];
#pragma unroll
                for (int q = 0; q < 2; ++q) { const v2u* xr = (const v2u*)(XB + (size_t)(m0 + q) * 1024) + lane;
#pragma unroll
                    for (int j = 0; j < 4; ++j) w[q][j] = xr[64 * j]; }
#pragma unroll
                for (int q = 0; q < 2; ++q) { float s = 0.f; f32x4 v[4];
#pragma unroll
                    for (int j = 0; j < 4; ++j) { v[j] = (f32x4){bf2f(w[q][j].x & 0xffffu), bf2f(w[q][j].x >> 16), bf2f(w[q][j].y & 0xffffu), bf2f(w[q][j].y >> 16)};
                        s += (v[j][0] * v[j][0] + v[j][1] * v[j][1]) + (v[j][2] * v[j][2] + v[j][3] * v[j][3]); }
                    const float r = 1.0f / sqrtf(wave_sum(s) * (1.0f / 1024.0f) + 1e-6f);
                    f32x4* orow = (f32x4*)(out + (size_t)(m0 + q) * 1024) + lane;
#pragma unroll
                    for (int j = 0; j < 4; ++j) { const f32x4 gg = *((const f32x4*)fg + lane + 64 * j); orow[64 * j] = v[j] * r * gg; } } }
        }
}

__global__ void __launch_bounds__(NWAVES * 64, 2) mk_fwd(Args args) {
    extern __shared__ __attribute__((aligned(16))) unsigned char lds[];
    cg::grid_group grid = cg::this_grid();
    volatile LAS unsigned* MISC = (volatile LAS unsigned*)((LAS unsigned char*)lds + LDS_BYTES - 128);
    const int wv_ = __builtin_amdgcn_readfirstlane(threadIdx.x >> 6);
    if (threadIdx.x < 32) MISC[threadIdx.x] = 0u;
    __syncthreads();
#ifndef DUPMASK
#define DUPMASK 0
#endif
#ifndef EXTRASYNC
#define EXTRASYNC 0
#endif
    { unsigned* rdy = (unsigned*)(args.ws + WS_RDY);
      if (blockIdx.x == 0) { for (int i = threadIdx.x; i < 4096; i += NWAVES * 64) ((unsigned*)(args.ws + WS_BAR))[i] = 0u;
          __threadfence(); __syncthreads();
          if (threadIdx.x == 0) __hip_atomic_store(rdy, BAR_MAGIC, __ATOMIC_RELEASE, __HIP_MEMORY_SCOPE_AGENT); }
      if (threadIdx.x == 0) { while (__hip_atomic_load(rdy, __ATOMIC_RELAXED, __HIP_MEMORY_SCOPE_AGENT) != BAR_MAGIC) __builtin_amdgcn_s_sleep(2);
          __builtin_amdgcn_fence(__ATOMIC_ACQUIRE, "agent"); }
      __syncthreads(); }
    const XcdBarrier bar = xcd_barrier_post((unsigned*)(args.ws + WS_BAR), MISC + 8, wv_);
    if (args.ws == nullptr) grid.sync();
    do_step<0>(args, lds, wv_); xcd_barrier(bar, wv_);
#define STEP_(k) do_step<k>(args, lds, wv_); xcd_barrier(bar, wv_); if constexpr ((DUPMASK >> k) & 1) { do_step<k>(args, lds, wv_); xcd_barrier(bar, wv_); }
    STEP_(1) STEP_(2) STEP_(3) STEP_(4) STEP_(5) STEP_(6) STEP_(7) STEP_(8) STEP_(9) STEP_(10) STEP_(11) STEP_(13) STEP_(14) STEP_(15)
    for (int i = 0; i < EXTRASYNC; ++i) xcd_barrier(bar, wv_);
    if (blockIdx.x == 0 && wv_ == 0 && mk_lane() == 0) __hip_atomic_store((unsigned*)(args.ws + WS_RDY), 0u, __ATOMIC_RELAXED, __HIP_MEMORY_SCOPE_AGENT);
    do_step<16>(args, lds, wv_);
#undef STEP_
}

extern "C" void kernel_launch(void* const* d_in, const int* in_sizes, int n_in, void* d_out, int out_size, void* d_ws, size_t ws_size, hipStream_t stream) {
    static int grid = 0;
    if (grid == 0) {
        if (n_in != 24 || out_size != M * DMODEL || ws_size < WS_END) { fprintf(stderr, "kernel_launch: unexpected shapes (n_in %d out %d ws %zu)\n", n_in, out_size, ws_size); grid = -1; return; }
        int dev = 0, cus = 0, per_cu = 0;
        hipGetDevice(&dev); hipDeviceGetAttribute(&cus, hipDeviceAttributeMultiprocessorCount, dev);
        if (hipFuncSetAttribute((const void*)mk_fwd, hipFuncAttributeMaxDynamicSharedMemorySize, LDS_BYTES) != hipSuccess) { fprintf(stderr, "kernel_launch: hipFuncSetAttribute failed\n"); grid = -1; return; }
        if (hipOccupancyMaxActiveBlocksPerMultiprocessor(&per_cu, (const void*)mk_fwd, NWAVES * 64, LDS_BYTES) != hipSuccess || per_cu < 1) { fprintf(stderr, "kernel_launch: occupancy query says %d\n", per_cu); per_cu = 1; }
        (void)hipGetLastError();
        grid = cus * per_cu;
    }
    if (grid < 0) return;
    Args a{};
    for (int i = 0; i < 24; ++i) a.in[i] = (const float*)d_in[i];
    a.out = (float*)d_out; a.ws = (unsigned char*)d_ws;
    void* kargs[] = {&a};
    hipError_t e = hipLaunchCooperativeKernel((const void*)mk_fwd, dim3(grid), dim3(NWAVES * 64), kargs, LDS_BYTES, stream);
    if (e != hipSuccess) fprintf(stderr, "cooperative launch failed: %s (grid %d)\n", hipGetErrorString(e), grid);
}
```

```cpp
#include <hip/hip_runtime.h>
#include <hip/hip_cooperative_groups.h>
#include <hip/hip_bf16.h>
#include <cstdio>
#include <cstdint>
#include <cmath>
__device__ __forceinline__ int mk_lane(){ int l_; asm volatile("v_mbcnt_lo_u32_b32 %0, -1, 0\n\tv_mbcnt_hi_u32_b32 %0, -1, %0" : "=v"(l_)); return l_; }
namespace pg8 {
#define PG8_LAS __attribute__((address_space(3)))
typedef unsigned short bf16_t;
typedef short bf16x8 __attribute__((ext_vector_type(8)));
typedef float f32x4 __attribute__((ext_vector_type(4)));
typedef unsigned u32x4 __attribute__((ext_vector_type(4)));
constexpr int BM = 256, BK = 64, HALF = 128, HTB = HALF * BK * 2  , STAGE_BYTES = 8 * HTB, NXCD = 8, WGM = 8;

__host__ __device__ __forceinline__ int lds_byte(int r, int c) { const int st = (r >> 4) * 2 + (c >> 5), rr = r & 15, cc = c & 31, ob = rr * 64 + cc * 2; return st * 1024 + (ob ^ (((ob >> 9) & 1) << 5)); }
__host__ __device__ __forceinline__ void stage_rc(int b, int& R, int& C) { const int st = b / 1024, sb = b % 1024, swz = sb ^ (((sb >> 9) & 1) << 5); R = (st >> 1) * 16 + swz / 64; C = (st & 1) * 32 + (swz % 64) / 2; }
__host__ __device__ __forceinline__ int perm32(int rho) { const int n = rho >> 4, i = rho & 15; return 8 * (i >> 2) + 4 * n + (i & 3); }

struct Unit { int pm, pn; };
struct Gemm { const bf16_t* A; const bf16_t* Bt; int M, N, K; };

struct StaticOrder {
    int nM, nN, nwg, G, c;
    __host__ __device__ void init(int M, int N, int G_, int c_) { nM = M / BM; nN = N / BM; nwg = nM * nN; G = G_; c = c_; }
    __host__ __device__ bool next(int i, Unit& u) const {
        const long L = (long)i * G + c; if (L >= nwg) return false;
        int wgid = (int)L; { const int q = nwg / NXCD, r = nwg % NXCD, xcd = wgid % NXCD, off = wgid / NXCD; wgid = (xcd < r ? xcd * (q + 1) : r * (q + 1) + (xcd - r) * q) + off; }
        const int nig = WGM * nN, gid = wgid / nig, fm = gid * WGM, gsz = (nM - fm) < WGM ? (nM - fm) : WGM;
        u.pm = fm + ((wgid % nig) % gsz); u.pn = (wgid % nig) / gsz; return true;
    }
    __device__ __forceinline__ void a_ready(const Unit&) const {}
    __device__ __forceinline__ void done(const Unit&) const {}
};

__device__ __forceinline__ unsigned cvt_pk_bf16(float lo, float hi) { unsigned r; asm volatile("v_cvt_pk_bf16_f32 %0, %1, %2" : "=v"(r) : "v"(lo), "v"(hi)); return r; }
typedef float f32x2 __attribute__((ext_vector_type(2)));
__device__ __forceinline__ f32x2 gelu_pk(f32x2 v) {
    const f32x2 av = __builtin_elementwise_abs(v), d = av * 0.2316418882f + 1.0f;
    f32x2 t; t.x = __builtin_amdgcn_rcpf(d.x); t.y = __builtin_amdgcn_rcpf(d.y);
    f32x2 q = t * 0.5307027145f + (-0.7265760135f); q = q * t + 0.7107068705f; q = q * t + (-0.142248368f); q = q * t + 0.127414796f; q = q * t;
    const f32x2 s = (v * v) * (-0.72134752044f);
    f32x2 e; e.x = __builtin_amdgcn_exp2f(s.x); e.y = __builtin_amdgcn_exp2f(s.y);
    const f32x2 m = v * (q * e), r = v - m;
    f32x2 o; o.x = v.x < 0.f ? m.x : r.x; o.y = v.y < 0.f ? m.y : r.y; return o;
}

template <int ACT  > struct EpiBf16 {
    static constexpr bool PERM = true, AFTER_DRAIN = false; static_assert(ACT == 0 || ACT == 1, "EpiBf16: ACT is 0 (none) or 1 (gelu_pk)");
    bf16_t* O; int ldc; const float* bias; int split_cols; size_t split_stride; float scale0;
    __device__ __forceinline__ void operator()(const f32x4 (&acc)[2][2][4][2], const Unit& u, int wr, int wc, int fr, int fq) const {
        const int row0 = u.pm * BM + wr * 64 + fr; int colt = u.pn * BM; bf16_t* base = O;
        float sc = 1.f; if (split_cols) { const int t = colt / split_cols; base += (size_t)t * split_stride; colt -= t * split_cols; if (t == 0) sc = scale0; }
        const int col0 = colt + wc * 32 + 8 * fq, bcol0 = u.pn * BM + wc * 32 + 8 * fq;
        f32x4 bv[2][2];
#pragma unroll
        for (int bj = 0; bj < 2; ++bj)
#pragma unroll
            for (int n = 0; n < 2; ++n) bv[bj][n] = bias ? *(const f32x4*)(bias + bcol0 + bj * HALF + 4 * n) : (f32x4){0.f, 0.f, 0.f, 0.f};
#pragma unroll
        for (int ai = 0; ai < 2; ++ai)
#pragma unroll
            for (int m = 0; m < 4; ++m) { bf16_t* rowp = base + (size_t)(row0 + ai * HALF + m * 16) * ldc + col0;
#pragma unroll
                for (int bj = 0; bj < 2; ++bj) { f32x4 v0 = acc[ai][bj][m][0] + bv[bj][0], v1 = acc[ai][bj][m][1] + bv[bj][1];
                    if (ACT == 1) { f32x2 a = gelu_pk((f32x2){v0[0], v0[1]}), b = gelu_pk((f32x2){v0[2], v0[3]}), c = gelu_pk((f32x2){v1[0], v1[1]}), d = gelu_pk((f32x2){v1[2], v1[3]});
                        v0 = (f32x4){a.x, a.y, b.x, b.y}; v1 = (f32x4){c.x, c.y, d.x, d.y}; }
                    v0 = v0 * sc; v1 = v1 * sc; u32x4 w; w.x = cvt_pk_bf16(v0[0], v0[1]); w.y = cvt_pk_bf16(v0[2], v0[3]); w.z = cvt_pk_bf16(v1[0], v1[1]); w.w = cvt_pk_bf16(v1[2], v1[3]);
                    *(u32x4*)(rowp + bj * HALF) = w; } }
    }
};

typedef unsigned u32x2 __attribute__((ext_vector_type(2)));
constexpr int SLOTS = 16;
constexpr float RMS_EPS = 1e-6f;
__device__ __forceinline__ void load_rstd(const float* ss, int row0, int fq, float (&rs)[2][4]) {
#pragma unroll
    for (int ai = 0; ai < 2; ++ai)
#pragma unroll
        for (int m = 0; m < 4; ++m) { const f32x4 a = *(const f32x4*)(ss + (size_t)(row0 + ai * HALF + m * 16) * SLOTS + 4 * fq);
            float s = (a[0] + a[1]) + (a[2] + a[3]); s += __shfl_xor(s, 16); s += __shfl_xor(s, 32);
            rs[ai][m] = __builtin_amdgcn_rsqf(s * (1.0f / 1024.0f) + RMS_EPS); }
}
__device__ __forceinline__ float silu_f(float g) { return g * __builtin_amdgcn_rcpf(1.0f + __builtin_amdgcn_exp2f(-1.4426950408889634f * g)); }
__device__ __forceinline__ float gelu_t(float x) { const float y = x * (1.0f + 0.044715f * x * x); return x * __builtin_amdgcn_rcpf(1.0f + __builtin_amdgcn_exp2f(-2.302208198f * y)); }

typedef float f32x2 __attribute__((ext_vector_type(2)));
__device__ __forceinline__ f32x2 swiglu_pk(f32x2 g, f32x2 u, f32x2 r2, f32x2 c2) {
    const f32x2 t = g * c2, gg = g * r2, uu = u * r2; f32x2 e; e.x = __builtin_amdgcn_exp2f(t.x); e.y = __builtin_amdgcn_exp2f(t.y);
    const f32x2 d = e + 1.0f; f32x2 sg; sg.x = __builtin_amdgcn_rcpf(d.x); sg.y = __builtin_amdgcn_rcpf(d.y);
    return (gg * sg) * uu;
}
__device__ __forceinline__ f32x2 gelu_pk2(f32x2 x) {
    const f32x2 y = x * ((x * x) * 0.044715f + 1.0f), t = y * (-2.302208198f); f32x2 e; e.x = __builtin_amdgcn_exp2f(t.x); e.y = __builtin_amdgcn_exp2f(t.y);
    const f32x2 d = e + 1.0f; f32x2 sg; sg.x = __builtin_amdgcn_rcpf(d.x); sg.y = __builtin_amdgcn_rcpf(d.y);
    return x * sg;
}
struct EpiSwiglu {
    static constexpr bool PERM = true, AFTER_DRAIN = false;
    bf16_t* H; int ldh; const float* ss;
    __device__ __forceinline__ void operator()(const f32x4 (&acc)[2][2][4][2], const Unit& u, int wr, int wc, int fr, int fq) const {
        const int row0 = u.pm * BM + wr * 64 + fr; float rs[2][4]; load_rstd(ss, row0, fq, rs);
        const int col0 = u.pn * HALF + wc * 32 + 8 * fq;
#pragma unroll
        for (int ai = 0; ai < 2; ++ai)
#pragma unroll
            for (int m = 0; m < 4; ++m) { const float r = rs[ai][m]; bf16_t* p = H + (size_t)(row0 + ai * HALF + m * 16) * ldh + col0;
                const f32x2 r2 = (f32x2){r, r}, c2 = r2 * (-1.4426950408889634f);
                const f32x4 g0 = acc[ai][0][m][0], g1 = acc[ai][0][m][1], u0 = acc[ai][1][m][0], u1 = acc[ai][1][m][1];
                const f32x2 h0 = swiglu_pk((f32x2){g0[0], g0[1]}, (f32x2){u0[0], u0[1]}, r2, c2), h1 = swiglu_pk((f32x2){g0[2], g0[3]}, (f32x2){u0[2], u0[3]}, r2, c2);
                const f32x2 h2 = swiglu_pk((f32x2){g1[0], g1[1]}, (f32x2){u1[0], u1[1]}, r2, c2), h3 = swiglu_pk((f32x2){g1[2], g1[3]}, (f32x2){u1[2], u1[3]}, r2, c2);
                u32x4 w; w.x = cvt_pk_bf16(h0.x, h0.y); w.y = cvt_pk_bf16(h1.x, h1.y); w.z = cvt_pk_bf16(h2.x, h2.y); w.w = cvt_pk_bf16(h3.x, h3.y);
                *(u32x4*)p = w; }
    }
};
struct EpiResid {
    static constexpr bool PERM = true, AFTER_DRAIN = false;
    bf16_t* xb; float* ss; float alpha;
    __device__ __forceinline__ void operator()(const f32x4 (&acc)[2][2][4][2], const Unit& u, int wr, int wc, int fr, int fq) const {
        const int row0 = u.pm * BM + wr * 64 + fr, col0 = u.pn * BM + wc * 32 + 8 * fq;
#pragma unroll
        for (int ai = 0; ai < 2; ++ai)
#pragma unroll
            for (int m = 0; m < 4; ++m) { const int row = row0 + ai * HALF + m * 16; const size_t off = (size_t)row * 1024 + col0; float q = 0.f;
#pragma unroll
                for (int bj = 0; bj < 2; ++bj) { u32x4* p = (u32x4*)(xb + off + bj * HALF); const u32x4 bw = *p;
                    const f32x4 b0 = (f32x4){__builtin_bit_cast(float, bw.x << 16), __builtin_bit_cast(float, bw.x & 0xffff0000u), __builtin_bit_cast(float, bw.y << 16), __builtin_bit_cast(float, bw.y & 0xffff0000u)};
                    const f32x4 b1 = (f32x4){__builtin_bit_cast(float, bw.z << 16), __builtin_bit_cast(float, bw.z & 0xffff0000u), __builtin_bit_cast(float, bw.w << 16), __builtin_bit_cast(float, bw.w & 0xffff0000u)};
                    const f32x4 o0 = b0 + acc[ai][bj][m][0] * alpha, o1 = b1 + acc[ai][bj][m][1] * alpha;
                    q += ((o0[0] * o0[0] + o0[1] * o0[1]) + (o0[2] * o0[2] + o0[3] * o0[3])) + ((o1[0] * o1[0] + o1[1] * o1[1]) + (o1[2] * o1[2] + o1[3] * o1[3]));
                    u32x4 w; w.x = cvt_pk_bf16(o0[0], o0[1]); w.y = cvt_pk_bf16(o0[2], o0[3]); w.z = cvt_pk_bf16(o1[0], o1[1]); w.w = cvt_pk_bf16(o1[2], o1[3]); *p = w; }
                q += __shfl_xor(q, 16); q += __shfl_xor(q, 32);
                if (fq == 0) ss[(size_t)row * SLOTS + u.pn * 4 + wc] = q;
                if (m & 1) asm volatile("" ::: "memory"); }
    }
};
struct EpiIn {
    static constexpr bool PERM = true, AFTER_DRAIN = false;
    bf16_t* dst; size_t sec_stride; int ntq; const float* ss; const float* rope; float* kmean; float qscale;
    __device__ __forceinline__ void operator()(const f32x4 (&acc)[2][2][4][2], const Unit& u, int wr, int wc, int fr, int fq) const {
        const int sec = u.pn / ntq, tcol = (u.pn - sec * ntq) * BM, pitch = ntq * BM;
        bf16_t* basep = dst + (size_t)sec * sec_stride;
        const int row0 = u.pm * BM + wr * 64 + fr; float rs[2][4]; load_rstd(ss, row0, fq, rs);
        const int col0 = tcol + wc * 32 + 8 * fq;
        const bool ropelane = (sec < 2) && ((wc & 1) == 0) && (fq < 2);
        const float qs = (sec == 0) ? qscale : 1.0f;
        const bool dokm = (sec == 1) && (kmean != nullptr);
        f32x4 ks[2][2];
#pragma unroll
        for (int bj = 0; bj < 2; ++bj)
#pragma unroll
            for (int n = 0; n < 2; ++n) ks[bj][n] = (f32x4){0.f, 0.f, 0.f, 0.f};
#pragma unroll
        for (int ai = 0; ai < 2; ++ai) {
            f32x4 csv[4][2];
#pragma unroll
            for (int m = 0; m < 4; ++m) { csv[m][0] = (f32x4){1.f, 0.f, 1.f, 0.f}; csv[m][1] = csv[m][0];
                if (ropelane) { const float* rp = rope + ((size_t)((row0 + ai * HALF + m * 16) & 8191) * 8 + 4 * fq) * 2; csv[m][0] = *(const f32x4*)rp; csv[m][1] = *(const f32x4*)(rp + 4); } }
#pragma unroll
            for (int m = 0; m < 4; ++m) { const int row = row0 + ai * HALF + m * 16; const float r = rs[ai][m]; bf16_t* rowp = basep + (size_t)row * pitch + col0;
                const f32x4 cs0 = csv[m][0], cs1 = csv[m][1];
#pragma unroll
                for (int bj = 0; bj < 2; ++bj) { f32x4 v0 = acc[ai][bj][m][0] * r, v1 = acc[ai][bj][m][1] * r;
                    if (sec < 2) {
                        if (ropelane) {
                            const f32x4 a = v0, b = v1;
                            v0 = (f32x4){a[0] * cs0[0] - a[1] * cs0[1], a[0] * cs0[1] + a[1] * cs0[0], a[2] * cs0[2] - a[3] * cs0[3], a[2] * cs0[3] + a[3] * cs0[2]};
                            v1 = (f32x4){b[0] * cs1[0] - b[1] * cs1[1], b[0] * cs1[1] + b[1] * cs1[0], b[2] * cs1[2] - b[3] * cs1[3], b[2] * cs1[3] + b[3] * cs1[2]};
                        }
                        v0 = v0 * qs; v1 = v1 * qs;
                        if (dokm) { ks[bj][0] += v0; ks[bj][1] += v1; }
                    } else if (sec >= 3) {
                        { const f32x2 a0 = gelu_pk2((f32x2){v0[0], v0[1]}), a1 = gelu_pk2((f32x2){v0[2], v0[3]}), b0 = gelu_pk2((f32x2){v1[0], v1[1]}), b1 = gelu_pk2((f32x2){v1[2], v1[3]});
                          v0 = (f32x4){a0.x, a0.y, a1.x, a1.y}; v1 = (f32x4){b0.x, b0.y, b1.x, b1.y}; }
                    }
                    u32x4 w; w.x = cvt_pk_bf16(v0[0], v0[1]); w.y = cvt_pk_bf16(v0[2], v0[3]); w.z = cvt_pk_bf16(v1[0], v1[1]); w.w = cvt_pk_bf16(v1[2], v1[3]);
                    *(u32x4*)(rowp + bj * HALF) = w; } }
            asm volatile("" ::: "memory"); }
        if (dokm) {
#pragma unroll
            for (int bj = 0; bj < 2; ++bj)
#pragma unroll
                for (int n = 0; n < 2; ++n)
#pragma unroll
                    for (int j = 0; j < 4; ++j) { float s = ks[bj][n][j]; s += __shfl_xor(s, 1); s += __shfl_xor(s, 2); s += __shfl_xor(s, 4); s += __shfl_xor(s, 8);
                        if (fr == 0) atomicAdd(kmean + (size_t)u.pm * 512 + col0 + bj * HALF + 4 * n + j, s * (1.0f / 256.0f)); }
        }
    }
};

template <class Epi, class Sched, bool ALIGN_EPI = false, bool SP2 = false>
__device__ __forceinline__ void gemm_phase(PG8_LAS unsigned char* lds, const Gemm g, const Sched& S, const Epi& E, const int wv_  ) {
    int tid_ = (mk_lane()+((wv_)<<6)); asm volatile("" : "+v"(tid_));
    const int tid = tid_, wid = __builtin_amdgcn_readfirstlane(tid >> 6), lane = tid & 63, wr = wid >> 2, wc = wid & 3, fr = lane & 15, fq = lane >> 4;
    const int K = g.K, nt = K / BK;
    unsigned voffA[2], voffB[2];
#pragma unroll
    for (int i = 0; i < 2; ++i) { int R, C; stage_rc(tid * 16 + i * 8192, R, C); const int Rb = Epi::PERM ? ((R & ~31) + perm32(R & 31)) : R;
        voffA[i] = (unsigned)(R * K + C) * 2u; voffB[i] = (unsigned)(Rb * K + C) * 2u; }
    const size_t kstep = (size_t)(BK * 2);
    const size_t hstep = (size_t)HALF * K * 2;
    const size_t tstep = 2 * hstep;
    const unsigned ldsw = (unsigned)wid * 1024u;
    const int aoff = lds_byte(wr * 64 + fr, fq * 8), boff = lds_byte(wc * 32 + fr, fq * 8);
#define PG8_SA(b, h) (((b) * 2 + (h)) * HTB)
#define PG8_SB(b, h) ((4 + (b) * 2 + (h)) * HTB)
#define PG8_STAGE(bufoff, gbase, voff) do { _Pragma("unroll") for (int _i = 0; _i < 2; ++_i) \
        __builtin_amdgcn_global_load_lds((const unsigned*)((const char*)(gbase) + (voff)[_i]), (PG8_LAS unsigned*)(lds + (bufoff) + ldsw + _i * 8192), 16, 0, 0); } while (0)
#define PG8_LDA(dst, b, h) do { _Pragma("unroll") for (int m = 0; m < 4; ++m) _Pragma("unroll") for (int k = 0; k < 2; ++k) dst[m][k] = *(const PG8_LAS bf16x8*)(lds + PG8_SA(b, h) + aoff + m * 2048 + k * 1024); } while (0)
#define PG8_LDB(dst, b, h) do { _Pragma("unroll") for (int n = 0; n < 2; ++n) _Pragma("unroll") for (int k = 0; k < 2; ++k) dst[n][k] = *(const PG8_LAS bf16x8*)(lds + PG8_SB(b, h) + boff + n * 2048 + k * 1024); } while (0)
#define PG8_MMA(ai, bj, At, Bt) do { __builtin_amdgcn_s_setprio(1); _Pragma("unroll") for (int m = 0; m < 4; ++m) _Pragma("unroll") for (int n = 0; n < 2; ++n) _Pragma("unroll") for (int k = 0; k < 2; ++k) \
        acc[ai][bj][m][n] = __builtin_amdgcn_mfma_f32_16x16x32_bf16(Bt[n][k], At[m][k], acc[ai][bj][m][n], 0, 0, 0); __builtin_amdgcn_s_setprio(0); } while (0)
#define PG8_WAIT_V(n) asm volatile("s_waitcnt vmcnt(" #n ")" ::: "memory")
#define PG8_WAIT_L(n) asm volatile("s_waitcnt lgkmcnt(" #n ")" ::: "memory")
#define PG8_BAR __builtin_amdgcn_s_barrier()
#define PG8_SCHED __builtin_amdgcn_sched_barrier(0)
    Unit cur, nxt; int ui = 0;
    if (!S.next(0, cur)) return;
    f32x4 acc[2][2][4][2];
#pragma unroll
    for (int a = 0; a < 2; ++a)
#pragma unroll
        for (int b = 0; b < 2; ++b)
#pragma unroll
            for (int m = 0; m < 4; ++m)
#pragma unroll
                for (int n = 0; n < 2; ++n) acc[a][b][m][n] = (f32x4){0.f, 0.f, 0.f, 0.f};
    bf16x8 At[4][2], B0[2][2], B1[2][2];
    const char* cA = (const char*)g.A + (size_t)cur.pm * tstep; const char* cB = (const char*)g.Bt + (size_t)cur.pn * tstep;
    S.a_ready(cur);
    if constexpr (SP2) {
        PG8_STAGE(PG8_SB(0, 0), cB, voffB); PG8_STAGE(PG8_SB(0, 1), cB + hstep, voffB); PG8_STAGE(PG8_SA(0, 0), cA, voffA); PG8_STAGE(PG8_SA(0, 1), cA + hstep, voffA);
        if (wr == 1) PG8_BAR;
        PG8_WAIT_V(2); PG8_BAR;
        PG8_STAGE(PG8_SB(1, 0), cB + kstep, voffB); PG8_STAGE(PG8_SA(1, 0), cA + kstep, voffA); PG8_STAGE(PG8_SB(1, 1), cB + hstep + kstep, voffB);
        PG8_WAIT_V(6); PG8_BAR;
    } else {
        PG8_STAGE(PG8_SB(0, 0), cB, voffB); PG8_STAGE(PG8_SA(0, 0), cA, voffA); PG8_STAGE(PG8_SB(0, 1), cB + hstep, voffB); PG8_STAGE(PG8_SA(0, 1), cA + hstep, voffA);
        if (wr == 1) PG8_BAR;
        PG8_WAIT_V(4); PG8_BAR;
        PG8_STAGE(PG8_SB(1, 0), cB + kstep, voffB); PG8_STAGE(PG8_SA(1, 0), cA + kstep, voffA); PG8_STAGE(PG8_SB(1, 1), cB + hstep + kstep, voffB);
        PG8_WAIT_V(6); PG8_BAR;
    }
    for (;;) {
        const bool has_next = S.next(ui + 1, nxt);
        const char* nA = has_next ? (const char*)g.A + (size_t)nxt.pm * tstep : cA; const char* nB = has_next ? (const char*)g.Bt + (size_t)nxt.pn * tstep : cB;
        for (int t = 0; t < nt; t += 2) {
            const bool last = (t == nt - 2);
            const char* a1 = cA + (size_t)(t + 1) * kstep;
            const char* a2 = last ? nA : cA + (size_t)(t + 2) * kstep; const char* b2 = last ? nB : cB + (size_t)(t + 2) * kstep;
            const char* a3 = a2 + kstep; const char* b3 = b2 + kstep;
            if (last && has_next) S.a_ready(nxt);
            if constexpr (SP2) {
            PG8_LDB(B0, 0, 0); PG8_LDB(B1, 0, 1); PG8_SCHED; PG8_LDA(At, 0, 0); PG8_STAGE(PG8_SA(1, 1), a1 + hstep, voffA);
            PG8_WAIT_V(8); PG8_WAIT_L(0); PG8_BAR; PG8_MMA(0, 0, At, B0); PG8_MMA(0, 1, At, B1); PG8_BAR; PG8_SCHED;
            PG8_LDA(At, 0, 1); PG8_STAGE(PG8_SB(0, 0), b2, voffB); PG8_STAGE(PG8_SB(0, 1), b2 + hstep, voffB); PG8_STAGE(PG8_SA(0, 0), a2, voffA);
            PG8_WAIT_V(8); PG8_WAIT_L(0); PG8_BAR; PG8_MMA(1, 0, At, B0); PG8_MMA(1, 1, At, B1); PG8_BAR; PG8_SCHED;
            PG8_LDB(B0, 1, 0); PG8_LDB(B1, 1, 1); PG8_SCHED; PG8_LDA(At, 1, 0); PG8_STAGE(PG8_SA(0, 1), a2 + hstep, voffA);
            PG8_WAIT_V(8); PG8_WAIT_L(0); PG8_BAR; PG8_MMA(0, 0, At, B0); PG8_MMA(0, 1, At, B1); PG8_BAR; PG8_SCHED;
            PG8_LDA(At, 1, 1); PG8_STAGE(PG8_SB(1, 0), b3, voffB); PG8_STAGE(PG8_SB(1, 1), b3 + hstep, voffB); PG8_STAGE(PG8_SA(1, 0), a3, voffA);
            PG8_WAIT_V(8); PG8_WAIT_L(0); PG8_BAR; PG8_MMA(1, 0, At, B0); PG8_MMA(1, 1, At, B1); PG8_BAR; PG8_SCHED;
            } else {
            PG8_LDB(B0, 0, 0); PG8_SCHED; PG8_LDA(At, 0, 0); PG8_STAGE(PG8_SA(1, 1), a1 + hstep, voffA);
            PG8_WAIT_L(8); PG8_BAR; PG8_WAIT_L(0); PG8_MMA(0, 0, At, B0); PG8_BAR; PG8_SCHED;
            PG8_LDB(B1, 0, 1); PG8_STAGE(PG8_SB(0, 0), b2, voffB);
            PG8_BAR; PG8_WAIT_L(0); PG8_MMA(0, 1, At, B1); PG8_BAR;
            PG8_LDA(At, 0, 1); PG8_STAGE(PG8_SA(0, 0), a2, voffA);
            PG8_BAR; PG8_WAIT_L(0); PG8_MMA(1, 0, At, B0); PG8_BAR; PG8_SCHED;
            PG8_STAGE(PG8_SB(0, 1), b2 + hstep, voffB);
            PG8_WAIT_V(6); PG8_BAR; PG8_MMA(1, 1, At, B1); PG8_BAR;
            PG8_LDB(B0, 1, 0); PG8_SCHED; PG8_LDA(At, 1, 0); PG8_STAGE(PG8_SA(0, 1), a2 + hstep, voffA);
            PG8_WAIT_L(8); PG8_BAR; PG8_WAIT_L(0); PG8_MMA(0, 0, At, B0); PG8_BAR; PG8_SCHED;
            PG8_LDB(B1, 1, 1); PG8_STAGE(PG8_SB(1, 0), b3, voffB);
            PG8_BAR; PG8_WAIT_L(0); PG8_MMA(0, 1, At, B1); PG8_BAR;
            PG8_LDA(At, 1, 1); PG8_STAGE(PG8_SA(1, 0), a3, voffA);
            PG8_BAR; PG8_WAIT_L(0); PG8_MMA(1, 0, At, B0); PG8_BAR; PG8_SCHED;
            PG8_STAGE(PG8_SB(1, 1), b3 + hstep, voffB);
            PG8_WAIT_V(6); PG8_BAR; PG8_MMA(1, 1, At, B1); PG8_BAR;
            }
        }
        if constexpr (ALIGN_EPI) { if (wr == 0) PG8_BAR; }
        if constexpr (!Epi::AFTER_DRAIN) { E(acc, cur, wr, wc, fr, fq); S.done(cur); }
        if (!has_next) break;
#pragma unroll
        for (int a = 0; a < 2; ++a)
#pragma unroll
            for (int b = 0; b < 2; ++b)
#pragma unroll
                for (int m = 0; m < 4; ++m)
#pragma unroll
                    for (int n = 0; n < 2; ++n) acc[a][b][m][n] = (f32x4){0.f, 0.f, 0.f, 0.f};
        cur = nxt; cA = nA; cB = nB; ++ui;
        if constexpr (ALIGN_EPI) { if (wr == 1) PG8_BAR; }
    }
    PG8_WAIT_V(0);
    if constexpr (!ALIGN_EPI) { if (wr == 0) PG8_BAR; }
    PG8_BAR;
    if constexpr (Epi::AFTER_DRAIN) { E.fused(acc, cur, wr, wc, fr, fq, lds, wid, lane); S.done(cur); }
#undef PG8_SA
#undef PG8_SB
#undef PG8_STAGE
#undef PG8_LDA
#undef PG8_LDB
#undef PG8_MMA
#undef PG8_WAIT_V
#undef PG8_WAIT_L
#undef PG8_BAR
#undef PG8_SCHED
}
}
namespace attn_body {
using bf16=__hip_bfloat16;
using bf16x8=__attribute__((ext_vector_type(8)))short;
using s16x4=__attribute__((ext_vector_type(4)))short;
using f32x16=__attribute__((ext_vector_type(16)))float;
using u32x4=__attribute__((ext_vector_type(4)))unsigned;
using f32x4m=__attribute__((ext_vector_type(4)))float;
constexpr int SEQ=8192,D=64;
constexpr int NW=8,QBLK=32,QB=QBLK*NW,KVBLK=64,NQB=SEQ/QB;

__device__ __forceinline__ int crow(int r,int hi){return (r&3)+8*(r>>2)+4*hi;}
#define SBAR() __builtin_amdgcn_sched_barrier(0)
__device__ __forceinline__ void cmask(f32x16&p0,f32x16&p1,int jb,int qrel,int hi){
  asm volatile("":"+v"(hi));
  const float NEG=-INFINITY; int kb=64*jb+4*hi;
  #pragma unroll
  for(int r=0;r<16;++r){int kv=kb+(r&3)+8*(r>>2); if(kv>qrel)p0[r]=NEG; if(kv+32>qrel)p1[r]=NEG;}
}

constexpr int NSLOT=3, SLOTB=8192;
constexpr int LDS_K=0, LDS_V=NSLOT*SLOTB, LDS_WS=2*NSLOT*SLOTB, LDS_OST=LDS_WS+NW*64*4, LDS_BYTES=LDS_OST+NW*4096;
constexpr float C2=0.125f*1.4426950408889634f;
__device__ __forceinline__ void glds16(const void*gsrc,unsigned lds_dst){unsigned keep;
  asm volatile("s_mov_b32 %0, m0\n\ts_mov_b32 m0, %2\n\ts_nop 0\n\tglobal_load_lds_dwordx4 %1, off\n\ts_mov_b32 m0, %0":"=&s"(keep):"v"(gsrc),"s"(lds_dst):"memory");}
__device__ __forceinline__ float max3f(float a,float b,float c){float r;asm("v_max3_f32 %0, %1, %2, %3":"=v"(r):"v"(a),"v"(b),"v"(c));return r;}
__device__ __forceinline__ float max2f(float a,float b){float r;asm("v_max_f32_e32 %0, %1, %2":"=v"(r):"v"(a),"v"(b));return r;}
__device__ __forceinline__ float fadd_s(float a,float b){float r;asm("v_add_f32_e32 %0, %1, %2":"=v"(r):"v"(a),"v"(b));return r;}
__device__ __forceinline__ float fsub_s(float a,float b){float r;asm("v_sub_f32_e32 %0, %1, %2":"=v"(r):"v"(a),"v"(b));return r;}
typedef float f32x2_t __attribute__((ext_vector_type(2))); typedef __bf16 bf16x2_t __attribute__((ext_vector_type(2)));
__device__ __forceinline__ unsigned cvtpk_s(float lo,float hi){f32x2_t v={lo,hi};bf16x2_t b=__builtin_convertvector(v,bf16x2_t);return __builtin_bit_cast(unsigned,b);}
#define WAIT_BAR(N) asm volatile("s_waitcnt vmcnt(" #N ") lgkmcnt(0)\n\ts_barrier":::"memory")

__device__ __forceinline__ void qkt(f32x16&p0,f32x16&p1,const char*Kslot,const bf16x8*qr,const f32x16&negm,int r32,int hi){
  const char*kb=Kslot+hi*1024+r32*16;
  #pragma unroll
  for(int d0=0;d0<4;++d0){
    const bf16x8 b0=*reinterpret_cast<const bf16x8*>(kb+d0*2048);
    const bf16x8 b1=*reinterpret_cast<const bf16x8*>(kb+d0*2048+512);
    if(d0==0){p0=__builtin_amdgcn_mfma_f32_32x32x16_bf16(b0,qr[0],negm,0,0,0);p1=__builtin_amdgcn_mfma_f32_32x32x16_bf16(b1,qr[0],negm,0,0,0);}
    else{p0=__builtin_amdgcn_mfma_f32_32x32x16_bf16(b0,qr[d0],p0,0,0,0);p1=__builtin_amdgcn_mfma_f32_32x32x16_bf16(b1,qr[d0],p1,0,0,0);}}
}
typedef __attribute__((address_space(3))) const char* lds_cptr;
typedef short v4i16_t __attribute__((ext_vector_type(4)));
__device__ __forceinline__ void kload8(bf16x8*kf,lds_cptr kp){
  kf[0]=*(const __attribute__((address_space(3))) bf16x8*)(kp);      kf[1]=*(const __attribute__((address_space(3))) bf16x8*)(kp+512);
  kf[2]=*(const __attribute__((address_space(3))) bf16x8*)(kp+2048); kf[3]=*(const __attribute__((address_space(3))) bf16x8*)(kp+2560);
  kf[4]=*(const __attribute__((address_space(3))) bf16x8*)(kp+4096); kf[5]=*(const __attribute__((address_space(3))) bf16x8*)(kp+4608);
  kf[6]=*(const __attribute__((address_space(3))) bf16x8*)(kp+6144); kf[7]=*(const __attribute__((address_space(3))) bf16x8*)(kp+6656);
}
__device__ __forceinline__ void kload2(bf16x8*kf,lds_cptr kp,int j){ kf[2*j]=*(const __attribute__((address_space(3))) bf16x8*)(kp+j*2048); kf[2*j+1]=*(const __attribute__((address_space(3))) bf16x8*)(kp+j*2048+512); }
__device__ __forceinline__ s16x4 vtr(lds_cptr p){ return __builtin_bit_cast(s16x4,__builtin_amdgcn_ds_read_tr16_b64_v4i16((__attribute__((address_space(3))) v4i16_t*)p)); }
__device__ __forceinline__ float rowmax(const f32x16&p0,const f32x16&p1){
  float a=max3f(p0[0],p0[1],p1[0]),b=max3f(p0[2],p0[3],p1[1]);a=max3f(a,p1[2],p1[3]);
  #pragma unroll
  for(int r=4;r<16;r+=4){a=max3f(a,p0[r],p0[r+1]);b=max3f(b,p0[r+2],p0[r+3]);a=max3f(a,p1[r],p1[r+1]);b=max3f(b,p1[r+2],p1[r+3]);}
  const float m=max2f(a,b);
  auto rr=__builtin_amdgcn_permlane32_swap(__float_as_uint(m),__float_as_uint(m),false,false);
  return max2f(__uint_as_float(rr[0]),__uint_as_float(rr[1]));
}
__device__ __forceinline__ void pv(f32x16*o,int vb,bf16x8 pa0,bf16x8 pa1,bf16x8 pa2,bf16x8 pa3){
  #pragma unroll
  for(int d0=0;d0<2;++d0){s16x4 lo[4],hi[4];
    #pragma unroll
    for(int ks=0;ks<4;++ks){
      asm volatile("ds_read_b64_tr_b16 %0,%1 offset:%c2":"=&v"(lo[ks]):"v"(vb),"i"(d0*4096+ks*1024):"memory");
      asm volatile("ds_read_b64_tr_b16 %0,%1 offset:%c2":"=&v"(hi[ks]):"v"(vb),"i"(d0*4096+ks*1024+512):"memory");}
    asm volatile("s_waitcnt lgkmcnt(0)":::"memory");SBAR();
    #define PK(k) (bf16x8){lo[k][0],lo[k][1],lo[k][2],lo[k][3],hi[k][0],hi[k][1],hi[k][2],hi[k][3]}
    o[d0]=__builtin_amdgcn_mfma_f32_32x32x16_bf16(pa0,PK(0),o[d0],0,0,0);
    o[d0]=__builtin_amdgcn_mfma_f32_32x32x16_bf16(pa1,PK(1),o[d0],0,0,0);
    o[d0]=__builtin_amdgcn_mfma_f32_32x32x16_bf16(pa2,PK(2),o[d0],0,0,0);
    o[d0]=__builtin_amdgcn_mfma_f32_32x32x16_bf16(pa3,PK(3),o[d0],0,0,0);
    #undef PK
  }
}

#ifndef ATTN_STORE16
#define ATTN_STORE16(p,v) (*(u32x4*)(p)=(v))
#endif
template<int THRL,int DM,int DMO,bool MOBA> __device__ __forceinline__ void attn_unit(int b,int hq,int hv,int qb,const bf16*Q,const bf16*__restrict__ K,const bf16*__restrict__ V,bf16*O,char*shm,const float*kmean,const int wv_){
  int tid=(mk_lane()+((wv_)<<6)); asm volatile("":"+v"(tid));
  const int lane=tid&63,r32=lane&31,hi=lane>>5; const int wid=__builtin_amdgcn_readfirstlane(tid>>6);
  const long rowbase=(long)b*SEQ; const int q0=qb*QB;
  const bf16*Qw=Q+(rowbase+q0+wid*QBLK)*DM+hq*D;
  const bf16*Kh=K+rowbase*DM+hq*D,*Vh=V+rowbase*DM+hv*D;
  const unsigned lds0=(unsigned)(uintptr_t)shm;
  float*wsf=(float*)(shm+LDS_WS)+wid*64;
  const bf16*ksrc=Kh+(long)lane*DM+wid*8;
  const bf16*vsrc=Vh+(long)(16*(wid&3)+(lane>>2))*DM+(wid>>2)*32+(lane&3)*8;
  const unsigned kdst=lds0+LDS_K+wid*1024, vdst=lds0+LDS_V+wid*1024;
  #define DMA_K(t,slot) glds16(ksrc+(long)(t)*KVBLK*DM,(unsigned)__builtin_amdgcn_readfirstlane(kdst+(slot)))
  #define DMA_V(t,slot) glds16(vsrc+(long)(t)*KVBLK*DM,(unsigned)__builtin_amdgcn_readfirstlane(vdst+(slot)))
  const int vb0=(int)(lds0+LDS_V)+((lane>>4)&1)*32+(lane&3)*8+(4*hi+((lane&15)>>2))*64;
  const char*Kbase=shm+LDS_K; bf16x8 kf[8];
  const lds_cptr shm3=(lds_cptr)shm; const lds_cptr kp0=shm3+LDS_K+hi*1024+r32*16; const lds_cptr vp0=shm3+LDS_V+((lane>>4)&1)*32+(lane&3)*8+(4*hi+((lane&15)>>2))*64;
  const int NT=(q0+QB)/KVBLK;
  DMA_K(0,0);DMA_V(0,0);DMA_K(1,SLOTB);
  bf16x8 qr[4];
  #pragma unroll
  for(int d0=0;d0<4;++d0)qr[d0]=*reinterpret_cast<const bf16x8*>(&Qw[(long)r32*DM+d0*16+hi*8]);
  unsigned selmask=0u;
  if constexpr(MOBA){ if(qb>0){
    const float*km=kmean+((size_t)(b*32+r32))*512+hq*64+hi*8;
    f32x16 g=f32x16{};
    #pragma unroll
    for(int d0=0;d0<4;++d0){ const f32x4m ka=*reinterpret_cast<const f32x4m*>(km+d0*16), kb=*reinterpret_cast<const f32x4m*>(km+d0*16+4);
      u32x4 w; w[0]=cvtpk_s(ka[0],ka[1]); w[1]=cvtpk_s(ka[2],ka[3]); w[2]=cvtpk_s(kb[0],kb[1]); w[3]=cvtpk_s(kb[2],kb[3]);
      g=__builtin_amdgcn_mfma_f32_32x32x16_bf16(__builtin_bit_cast(bf16x8,w),qr[d0],g,0,0,0); }
    int hi2=hi; asm volatile("":"+v"(hi2));
    float m1=-INFINITY,m2=-INFINITY,m3=-INFINITY;
    #define INS3(v_) do{ float t_=(v_); const float n1_=fmaxf(m1,t_); t_=fminf(m1,t_); m1=n1_; const float n2_=fmaxf(m2,t_); t_=fminf(m2,t_); m2=n2_; m3=fmaxf(m3,t_); }while(0)
    #pragma unroll
    for(int r=0;r<16;++r){ const int j=crow(r,hi2); const float v=(j<qb)?g[r]:-INFINITY; g[r]=v; INS3(v); }
    { auto x1=__builtin_amdgcn_permlane32_swap(__float_as_uint(m1),__float_as_uint(m1),false,false); auto x2=__builtin_amdgcn_permlane32_swap(__float_as_uint(m2),__float_as_uint(m2),false,false);
      auto x3=__builtin_amdgcn_permlane32_swap(__float_as_uint(m3),__float_as_uint(m3),false,false);
      m1=-INFINITY; m2=-INFINITY; m3=-INFINITY;
      INS3(__uint_as_float(x1[0])); INS3(__uint_as_float(x1[1])); INS3(__uint_as_float(x2[0])); INS3(__uint_as_float(x2[1])); INS3(__uint_as_float(x3[0])); INS3(__uint_as_float(x3[1])); }
    #undef INS3
    unsigned mk=0u;
    #pragma unroll
    for(int r=0;r<16;++r){ const int j=crow(r,hi2); if(j<qb && g[r]>=m3) mk|=(1u<<j); }
    { auto xm=__builtin_amdgcn_permlane32_swap(mk,mk,false,false); mk=xm[0]|xm[1]; }
    selmask=mk; } }
  #define MBIAS(P0,P1,t,band) do{ if constexpr(MOBA){ const float bs_=((band)||((selmask>>((t)>>2))&1u))?-mhat:-1e30f; _Pragma("unroll") for(int r=0;r<16;++r){P0[r]+=bs_;P1[r]+=bs_;} } }while(0)
  float mhat=0.f,l_reg=0.f;f32x16 o[2];o[0]=f32x16{};o[1]=f32x16{};f32x16 negm=f32x16{};if constexpr(!MOBA){asm volatile("":"+v"(negm));}
  const int qrel=wid*QBLK+r32;
  #define CMASK(P0,P1,t) do{int jb_=(t)-(NT-4); MBIAS(P0,P1,t,jb_>=0); if(jb_>=0)cmask(P0,P1,jb_,qrel,hi);}while(0)
  bool resc=false;
  #define START(P0,P1) do{ const float rm=rowmax(P0,P1); resc=false; \
    { const float dl=MOBA?__builtin_fmaxf(rm,-100.f):rm; mhat=fadd_s(mhat,dl); \
      _Pragma("unroll") for(int r=0;r<16;++r){P0[r]=fsub_s(P0[r],dl);P1[r]=fsub_s(P1[r],dl);} \
      if constexpr(!MOBA){ _Pragma("unroll") for(int r=0;r<16;++r)negm[r]=-mhat; asm volatile("":"+v"(negm)); } } \
    _Pragma("unroll") for(int r=0;r<16;++r)P0[r]=__builtin_amdgcn_exp2f(P0[r]); }while(0)
  #define RESC() do{ if(resc){ asm volatile("s_waitcnt lgkmcnt(0)":::"memory"); \
      _Pragma("unroll") for(int d_=0;d_<2;++d_) _Pragma("unroll") for(int r=0;r<16;++r)o[d_][r]*=wsf[crow(r,hi)]; } }while(0)
  f32x16 pA0,pA1,pB0,pB1;
  int sl_prev=0,sl_cur=0,sl_next=SLOTB;
  #define ROT() do{sl_prev=sl_cur;sl_cur=sl_next;sl_next=(sl_next==(NSLOT-1)*SLOTB)?0:sl_next+SLOTB;}while(0)
  DMA_K(2,2*SLOTB);
  WAIT_BAR(3);
  qkt(pA0,pA1,Kbase,qr,negm,r32,hi);asm volatile("s_nop 15\n\ts_nop 7":"+v"(pA0),"+v"(pA1));CMASK(pA0,pA1,0);
  START(pA0,pA1);
  _Pragma("unroll") for(int r=0;r<16;++r)pA1[r]=__builtin_amdgcn_exp2f(pA1[r]);
  WAIT_BAR(0);
  DMA_K(3,0);DMA_V(1,SLOTB);
  ROT();
  kload8(kf,kp0+sl_cur);
  WAIT_BAR(2);
  s16x4 vlo[8],vhi[8]; u32x4 pw0,pw1,pw2,pw3;
  #define PKW(P,B) cvtpk_s(P[B],P[B+1])
  #define PAF(k) __builtin_bit_cast(bf16x8,pw##k)
  #define VFR(i) (bf16x8){vlo[i][0],vlo[i][1],vlo[i][2],vlo[i][3],vhi[i][0],vhi[i][1],vhi[i][2],vhi[i][3]}
  #define PIN(x) asm volatile("":"+v"(x))
  #define MX3(a,b,c) __builtin_fmaxf(__builtin_fmaxf((a),(b)),(c))
  #define GAPA(MF,A0,A1,A2,A3,W0,W1,PW) do{ MF; sacc+=A0; sacc+=A1; sacc+=A2; sacc+=A3; PIN(sacc); W0; W1; PIN(PW); SBAR(); }while(0)
  #define EX(v) __builtin_amdgcn_exp2f(v)
  #define GAPB(MF,X,B) do{ MF; X[B]=EX(X[B]); X[B+1]=EX(X[B+1]); X[B+2]=EX(X[B+2]); X[B+3]=EX(X[B+3]); PIN(X); SBAR(); }while(0)
  #define VRD(i) do{ vlo[i]=vtr(vp_+(((i)>>2)*4096+((i)&3)*1024)); vhi[i]=vtr(vp_+(((i)>>2)*4096+((i)&3)*1024+512)); }while(0)
  #define KRD(G,j) do{ if(G){ kload2(kf,kp0+sl_next,j); SBAR(); } }while(0)
  #define STEP(C0,C1,P0,P1,t,GK,GV,GL) do{ SBAR(); \
    const lds_cptr vp_=vp0+sl_prev; \
    VRD(0); SBAR(); float sacc=(P0[0]+P0[1]); \
    GAPA(C0=__builtin_amdgcn_mfma_f32_32x32x16_bf16(kf[0],qr[0],negm,0,0,0), P0[2],P0[3],P0[4],P0[5],     pw0[0]=PKW(P0,0), pw0[1]=PKW(P0,2), pw0); \
    VRD(4); SBAR(); GAPA(C1=__builtin_amdgcn_mfma_f32_32x32x16_bf16(kf[1],qr[0],negm,0,0,0), P0[6],P0[7],P0[8],P0[9],     pw0[2]=PKW(P0,4), pw0[3]=PKW(P0,6), pw0); \
    VRD(1); SBAR(); GAPA(C0=__builtin_amdgcn_mfma_f32_32x32x16_bf16(kf[2],qr[1],C0,0,0,0),   P0[10],P0[11],P0[12],P0[13], pw1[0]=PKW(P0,8), pw1[1]=PKW(P0,10), pw1); \
    VRD(5); SBAR(); GAPA(C1=__builtin_amdgcn_mfma_f32_32x32x16_bf16(kf[3],qr[1],C1,0,0,0),   P0[14],P0[15],P1[0],P1[1],   pw1[2]=PKW(P0,12),pw1[3]=PKW(P0,14), pw1); \
    VRD(2); SBAR(); GAPA(C0=__builtin_amdgcn_mfma_f32_32x32x16_bf16(kf[4],qr[2],C0,0,0,0),   P1[2],P1[3],P1[4],P1[5],     pw2[0]=PKW(P1,0), pw2[1]=PKW(P1,2), pw2); \
    VRD(6); SBAR(); GAPA(C1=__builtin_amdgcn_mfma_f32_32x32x16_bf16(kf[5],qr[2],C1,0,0,0),   P1[6],P1[7],P1[8],P1[9],     pw2[2]=PKW(P1,4), pw2[3]=PKW(P1,6), pw2); \
    VRD(3); SBAR(); GAPA(C0=__builtin_amdgcn_mfma_f32_32x32x16_bf16(kf[6],qr[3],C0,0,0,0),   P1[10],P1[11],P1[12],P1[13], pw3[0]=PKW(P1,8), pw3[1]=PKW(P1,10), pw3); \
    VRD(7); SBAR(); GAPA(C1=__builtin_amdgcn_mfma_f32_32x32x16_bf16(kf[7],qr[3],C1,0,0,0),   P1[14],P1[15],0.f,0.f,       pw3[2]=PKW(P1,12),pw3[3]=PKW(P1,14), pw3); \
    l_reg+=sacc; \
    if(GK){DMA_K((t)+3,sl_cur);} if(GV){DMA_V((t)+1,sl_next);} \
    CMASK(C0,C1,t); \
    { float a=MX3(C0[0],C0[1],C1[0]),b=MX3(C0[2],C0[3],C1[1]); a=MX3(a,C1[2],C1[3]); \
      _Pragma("unroll") for(int r=4;r<16;r+=4){a=MX3(a,C0[r],C0[r+1]);b=MX3(b,C0[r+2],C0[r+3]);a=MX3(a,C1[r],C1[r+1]);b=MX3(b,C1[r+2],C1[r+3]);} \
      float rm=__builtin_fmaxf(a,b); { auto rr=__builtin_amdgcn_permlane32_swap(__float_as_uint(rm),__float_as_uint(rm),false,false); rm=__builtin_fmaxf(__uint_as_float(rr[0]),__uint_as_float(rr[1])); } \
      resc=false; \
      if(__builtin_expect(__any(rm>(float)THRL),0)){ const float dl=__builtin_fmaxf(rm,0.f); mhat+=dl; \
        _Pragma("unroll") for(int r=0;r<16;++r){C0[r]-=dl;C1[r]-=dl;} \
        if constexpr(!MOBA){ _Pragma("unroll") for(int r=0;r<16;++r)negm[r]=-mhat; asm volatile("":"+v"(negm)); } \
        const float f=__builtin_amdgcn_exp2f(-dl); l_reg*=f; if(hi==0)wsf[r32]=f; resc=true; } } \
    SBAR(); \
    GAPB(o[0]=__builtin_amdgcn_mfma_f32_32x32x16_bf16(PAF(0),VFR(0),o[0],0,0,0), C0,0); \
    GAPB(o[1]=__builtin_amdgcn_mfma_f32_32x32x16_bf16(PAF(0),VFR(4),o[1],0,0,0), C0,4); \
    KRD(GL,0); GAPB(o[0]=__builtin_amdgcn_mfma_f32_32x32x16_bf16(PAF(1),VFR(1),o[0],0,0,0), C0,8); \
    KRD(GL,1); GAPB(o[1]=__builtin_amdgcn_mfma_f32_32x32x16_bf16(PAF(1),VFR(5),o[1],0,0,0), C0,12); \
    KRD(GL,2); GAPB(o[0]=__builtin_amdgcn_mfma_f32_32x32x16_bf16(PAF(2),VFR(2),o[0],0,0,0), C1,0); \
    KRD(GL,3); GAPB(o[1]=__builtin_amdgcn_mfma_f32_32x32x16_bf16(PAF(2),VFR(6),o[1],0,0,0), C1,4); \
    GAPB(o[0]=__builtin_amdgcn_mfma_f32_32x32x16_bf16(PAF(3),VFR(3),o[0],0,0,0), C1,8); \
    GAPB(o[1]=__builtin_amdgcn_mfma_f32_32x32x16_bf16(PAF(3),VFR(7),o[1],0,0,0), C1,12); \
    }while(0)
  int t=1;
  #undef CMASK
  #define CMASK(P0,P1,t) MBIAS(P0,P1,t,false)
  for(;t+5<NT;t+=2){
    STEP(pB0,pB1,pA0,pA1,t,true,true,true);     WAIT_BAR(2); RESC(); ROT();
    STEP(pA0,pA1,pB0,pB1,t+1,true,true,true);   WAIT_BAR(2); RESC(); ROT();
  }
  #undef CMASK
  #define CMASK(P0,P1,t) do{int jb_=(t)-(NT-4); MBIAS(P0,P1,t,jb_>=0); if(jb_>=0)cmask(P0,P1,jb_,qrel,hi);}while(0)
  #define ENDW(tt) do{ if((tt)+3<NT){WAIT_BAR(2);} else if((tt)+2<NT){WAIT_BAR(1);} else {WAIT_BAR(0);} }while(0)
  for(;t+1<NT;t+=2){
    STEP(pB0,pB1,pA0,pA1,t,(t+3<NT),(t+1<NT),(t+1<NT));       ENDW(t);   RESC(); ROT();
    STEP(pA0,pA1,pB0,pB1,t+1,(t+4<NT),(t+2<NT),(t+2<NT));     ENDW(t+1); RESC(); ROT();
  }
  STEP(pB0,pB1,pA0,pA1,NT-1,false,false,false); RESC();
  { float sacc=pB0[0]+pB0[1]; _Pragma("unroll") for(int r=2;r<16;++r)sacc+=pB0[r]; _Pragma("unroll") for(int r=0;r<16;++r)sacc+=pB1[r]; l_reg+=sacc;
    pw0=(u32x4){PKW(pB0,0),PKW(pB0,2),PKW(pB0,4),PKW(pB0,6)};pw1=(u32x4){PKW(pB0,8),PKW(pB0,10),PKW(pB0,12),PKW(pB0,14)};pw2=(u32x4){PKW(pB1,0),PKW(pB1,2),PKW(pB1,4),PKW(pB1,6)};pw3=(u32x4){PKW(pB1,8),PKW(pB1,10),PKW(pB1,12),PKW(pB1,14)};
    SBAR(); pv(o,vb0+sl_cur,PAF(0),PAF(1),PAF(2),PAF(3)); }
  #undef PKW
  #undef PAF
  #undef VFR
  #undef PIN
  #undef MX3
  #undef GAPA
  #undef GAPB
  #undef EX
  #undef VRD
  #undef KRD
  #undef STEP
  #undef ENDW
  {auto rr=__builtin_amdgcn_permlane32_swap(__float_as_uint(l_reg),__float_as_uint(l_reg),false,false);l_reg=__uint_as_float(rr[0])+__uint_as_float(rr[1]);}
  if(hi==0)wsf[32+r32]=l_reg;asm volatile("s_waitcnt lgkmcnt(0)":::"memory");
  float rli[16];
  #pragma unroll
  for(int r=0;r<16;++r)rli[r]=__builtin_amdgcn_rcpf(wsf[32+crow(r,hi)]);
  bf16*Ow=O+(rowbase+q0+wid*QBLK)*DMO+hv*D;
  { bf16*stg=(bf16*)(shm+LDS_OST)+wid*2048;
    #pragma unroll
    for(int r=0;r<16;++r){const int orow=crow(r,hi);
      #pragma unroll
      for(int d0=0;d0<2;++d0)stg[orow*64+d0*32+r32]=__float2bfloat16(o[d0][r]*rli[r]);}
    asm volatile("s_waitcnt lgkmcnt(0)":::"memory");
    #pragma unroll
    for(int i=0;i<4;++i){const int row=i*8+(lane>>3),ch=lane&7; const u32x4 v=*(const u32x4*)(stg+row*64+ch*8); ATTN_STORE16(Ow+(long)row*DMO+ch*8,v);} }
  asm volatile("s_waitcnt lgkmcnt(0)\n\ts_barrier":::"memory");
  #undef DMA_K
  #undef DMA_V
  #undef CMASK
  #undef START
  #undef RESC
  #undef ROT
  #undef MBIAS
}
__device__ __forceinline__ void glds16s(const void*sbase,unsigned voff,unsigned lds_dst){unsigned keep;
  asm volatile("s_mov_b32 %0, m0\n\ts_mov_b32 m0, %3\n\ts_nop 0\n\tglobal_load_lds_dwordx4 %1, %2\n\ts_mov_b32 m0, %0":"=&s"(keep):"v"(voff),"s"(sbase),"s"(lds_dst):"memory");}
constexpr int L2_K=0, L2_V=4*8192, L2_WS=L2_V+4*16384, L2_OST=L2_WS+2048, L2_BYTES=L2_OST+NW*4096;
template<int THRL,int DM,int EXPM=0> __device__ __forceinline__ void attn_unit2(int b,int hq,int hv,int qb,const bf16*Q,const bf16*__restrict__ K,const bf16*__restrict__ V,bf16*O,char*shm,int combine,const float*sg,const float*lamp,float oscale,int desc,const int wv_){
  int tid=(mk_lane()+((wv_)<<6)); asm volatile("":"+v"(tid));
  const int lane=tid&63,r32=lane&31,hi=lane>>5; const int wid=__builtin_amdgcn_readfirstlane(tid>>6);
  const long rowbase=(long)b*SEQ; const int q0=qb*QB;
  const bf16*Qw=Q+(rowbase+q0+wid*QBLK)*DM+hq*D;
  const bf16*Kh=K+rowbase*DM+hq*D,*Vh=V+rowbase*DM+hv*128;
  const unsigned lds0=(unsigned)(uintptr_t)shm;
  float*wsf=(float*)(shm+L2_WS)+wid*64;
  const bf16*ksb=Kh+wid*8; const unsigned kvo=(unsigned)lane*DM*2u;
  const bf16*vsb=Vh+(long)(16*(wid&3))*DM+(wid>>2)*32; const unsigned vvo=((unsigned)(lane>>2)*DM+(lane&3)*8)*2u;
  const unsigned kdst=lds0+L2_K+wid*1024, vdst=lds0+L2_V+wid*1024;
  #define DMAK(t,soff) if constexpr(!(EXPM&4)) glds16s(ksb+(long)(t)*KVBLK*DM,kvo,(unsigned)__builtin_amdgcn_readfirstlane(kdst+(soff)))
  #define DMAV(t,soff) do{ if constexpr(!(EXPM&4)){ glds16s(vsb+(long)(t)*KVBLK*DM,vvo,(unsigned)__builtin_amdgcn_readfirstlane(vdst+(soff))); } if constexpr(!(EXPM&4)) glds16s(vsb+(long)(t)*KVBLK*DM+64,vvo,(unsigned)__builtin_amdgcn_readfirstlane(vdst+(soff)+8192)); }while(0)
  const lds_cptr shm3=(lds_cptr)shm; const lds_cptr kp0=shm3+L2_K+hi*1024+r32*16; const lds_cptr vp0=shm3+L2_V+((lane>>4)&1)*32+(lane&3)*8+(4*hi+((lane&15)>>2))*64;
  const int NT=(q0+QB)/KVBLK;
  #define TI(j) (desc?NT-1-(j):(j))
  if(wid>=4) __builtin_amdgcn_s_setprio(1);
  DMAK(TI(0),0);
  bf16x8 qr[4];
  #pragma unroll
  for(int d0=0;d0<4;++d0)qr[d0]=*reinterpret_cast<const bf16x8*>(&Qw[(long)r32*DM+d0*16+hi*8]);
  asm volatile(""::"v"(qr[0]),"v"(qr[1]),"v"(qr[2]),"v"(qr[3]));
  DMAV(TI(0),0); DMAK(TI(1),8192); DMAV(TI(1),16384); DMAK(TI(2),16384);
  float mhat=0.f,l_reg=0.f; f32x16 o[4]; o[0]=f32x16{};o[1]=f32x16{};o[2]=f32x16{};o[3]=f32x16{};
  const f32x16 zero=f32x16{};
  bool resc=false;
  #define EX2(v) __builtin_amdgcn_exp2f(v)
  #define PIN2(x) asm volatile("":"+v"(x))
  #define MX3(a,b,c) __builtin_fmaxf(__builtin_fmaxf((a),(b)),(c))
  #define ROWMAX_FIN(a_,b_) do{ rm=__builtin_fmaxf(a_,b_); auto rr_=__builtin_amdgcn_permlane32_swap(__float_as_uint(rm),__float_as_uint(rm),false,false); rm=__builtin_fmaxf(__uint_as_float(rr_[0]),__uint_as_float(rr_[1])); }while(0)
  f32x16 pA0,pA1,pB0,pB1; float rm;
  WAIT_BAR(6);
  qkt(pA0,pA1,shm+L2_K,qr,zero,r32,hi);
  { const int jb0_=TI(0)-(NT-4); if(jb0_>=0) cmask(pA0,pA1,jb0_,wid*QBLK+r32,hi); }
  { float a_=MX3(pA0[0],pA0[1],pA1[0]),b_=MX3(pA0[2],pA0[3],pA1[1]); a_=MX3(a_,pA1[2],pA1[3]);
    #pragma unroll
    for(int r=4;r<16;r+=4){a_=MX3(a_,pA0[r],pA0[r+1]);b_=MX3(b_,pA0[r+2],pA0[r+3]);a_=MX3(a_,pA1[r],pA1[r+1]);b_=MX3(b_,pA1[r+2],pA1[r+3]);}
    ROWMAX_FIN(a_,b_); mhat=__builtin_fmaxf(rm,-64.f);
    #pragma unroll
    for(int r=0;r<16;++r){pA0[r]-=mhat;pA1[r]-=mhat;} }
  f32x16 negm;
  #pragma unroll
  for(int r=0;r<16;++r)negm[r]=-mhat;
  asm volatile("":"+v"(negm));
  const bool grpB=false;
  #define TOPBLK(tt) do{ if constexpr(!(EXPM&8)){ if((tt)+2<NT){ WAIT_BAR(3); } else if((tt)+1<NT){ WAIT_BAR(2); } else { WAIT_BAR(0); } } \
    if((tt)+2<NT){ DMAV(TI((tt)+2),(((tt)+2)&3)*16384); } if((tt)+3<NT){ DMAK(TI((tt)+3),(((tt)+3)&3)*8192); } }while(0)
  if(grpB) TOPBLK(0);
  #define EXP4(P,B) do{ if constexpr(!(EXPM&1)){ P[B]=EX2(P[B]); P[B+1]=EX2(P[B+1]); P[B+2]=EX2(P[B+2]); P[B+3]=EX2(P[B+3]); } }while(0)
  #define KL(i) if constexpr(!(EXPM&16)) kf[(i)&3]=*(const __attribute__((address_space(3))) bf16x8*)(kp0+kn+((i)>>1)*2048+((i)&1)*512)
  #define VOFFL(i) (((i)&1)*4096+((i)>>1)*1024)
  #define VRDL(i) do{ if constexpr(!(EXPM&16)){ vl[i]=vtr(vp_+VOFFL(i)); vh[i]=vtr(vp_+VOFFL(i)+512); } }while(0)
  #define VRDH(i) do{ if constexpr(!(EXPM&18)){ vl[i]=vtr(vp_+8192+VOFFL(i)); vh[i]=vtr(vp_+8192+VOFFL(i)+512); } }while(0)
  #define VFR2(i) (bf16x8){vl[i][0],vl[i][1],vl[i][2],vl[i][3],vh[i][0],vh[i][1],vh[i][2],vh[i][3]}
  #define PAF2(k) __builtin_bit_cast(bf16x8,pw[k])
  #define PKW2(P,B) cvtpk_s(P[B],P[B+1])
  #define G1(i,PNX,CIN,PC,PCB) do{ PNX=__builtin_amdgcn_mfma_f32_32x32x16_bf16(kf[(i)&3],qr[(i)>>1],CIN,0,0,0); if((i)<4){KL((i)+4);} VRDL(i); if((PCB)>=0){ EXP4(PC,((PCB)>=0?(PCB):0)); PIN2(PC); } SBAR(); }while(0)
  #define G2A(j,PC,PCB,HN,PN,PNB) do{ const bf16x8 vf_=VFR2(j); VRDH(j); o[(j)&1]=__builtin_amdgcn_mfma_f32_32x32x16_bf16(PAF2((j)>>1),vf_,o[(j)&1],0,0,0); \
      sacc+=PC[PCB]; sacc+=PC[PCB+1]; sacc+=PC[PCB+2]; sacc+=PC[PCB+3]; PIN2(sacc); \
      if(HN){ ma=MX3(ma,PN[PNB],PN[PNB+1]); ma=MX3(ma,PN[PNB+2],PN[PNB+3]); PIN2(ma); } SBAR(); }while(0)
  #define G2B(j) do{ if constexpr(!(EXPM&2)){ const bf16x8 vf_=VFR2(j); o[2+((j)&1)]=__builtin_amdgcn_mfma_f32_32x32x16_bf16(PAF2((j)>>1),vf_,o[2+((j)&1)],0,0,0); SBAR(); } }while(0)
  #define STEP2(PC0,PC1,PN0,PN1,t,HN) do{ \
    if(!grpB){ TOPBLK(t); }                         \
    const int kn=(((t)+1)&3)*8192, vc=((t)&3)*16384; \
    if(resc){ const float*wp_=(const float*)(shm+L2_WS)+wid*64+4*(mk_lane()>>5); _Pragma("unroll") for(int r=0;r<16;++r){ const float f_=wp_[(r&3)+8*(r>>2)]; o[0][r]*=f_; o[1][r]*=f_; o[2][r]*=f_; o[3][r]*=f_; } } \
    bf16x8 kf[4]; const lds_cptr vp_=vp0+vc; s16x4 vl[8],vh[8]; \
    if(HN){ KL(0); KL(1); KL(2); KL(3); } \
    SBAR(); \
    if(HN){ \
      EXP4(PC0,0); EXP4(PC0,4); PIN2(PC0); SBAR();                    \
      G1(0,PN0,negm,PC0,8); G1(1,PN1,negm,PC0,12); G1(2,PN0,PN0,PC1,0); G1(3,PN1,PN1,PC1,4); \
      G1(4,PN0,PN0,PC1,8);  G1(5,PN1,PN1,PC1,12);  G1(6,PN0,PN0,PC1,-1); G1(7,PN1,PN1,PC1,-1); \
    } else { VRDL(0); VRDL(1); VRDL(2); VRDL(3); VRDL(4); VRDL(5); VRDL(6); VRDL(7); \
      EXP4(PC0,0); EXP4(PC0,4); EXP4(PC0,8); EXP4(PC0,12); EXP4(PC1,0); EXP4(PC1,4); EXP4(PC1,8); EXP4(PC1,12); } \
    u32x4 pw[4]; pw[0]=(u32x4){PKW2(PC0,0),PKW2(PC0,2),PKW2(PC0,4),PKW2(PC0,6)}; pw[1]=(u32x4){PKW2(PC0,8),PKW2(PC0,10),PKW2(PC0,12),PKW2(PC0,14)}; \
    pw[2]=(u32x4){PKW2(PC1,0),PKW2(PC1,2),PKW2(PC1,4),PKW2(PC1,6)}; pw[3]=(u32x4){PKW2(PC1,8),PKW2(PC1,10),PKW2(PC1,12),PKW2(PC1,14)}; \
    if(HN){ const int jb_=TI((t)+1)-(NT-4); if(jb_>=0){ const int ln_=mk_lane(); cmask(PN0,PN1,jb_,wid*QBLK+(ln_&31),ln_>>5); } } \
    if(grpB){ if((t)+1<NT){ TOPBLK((t)+1); } else { if constexpr(!(EXPM&8)){ WAIT_BAR(0); } } } \
    float sacc=0.f,ma=-INFINITY; SBAR(); \
    G2A(0,PC0,0,HN,PN0,0);  G2A(1,PC0,4,HN,PN0,4);  G2A(2,PC0,8,HN,PN0,8);   G2A(3,PC0,12,HN,PN0,12); \
    G2A(4,PC1,0,HN,PN1,0);  G2A(5,PC1,4,HN,PN1,4);  G2A(6,PC1,8,HN,PN1,8);   G2A(7,PC1,12,HN,PN1,12); \
    G2B(0); G2B(1); G2B(2); G2B(3); G2B(4); G2B(5); G2B(6); G2B(7); \
    l_reg+=sacc; resc=false; \
    if(HN){ ROWMAX_FIN(ma,ma); \
      if(__any(rm>(float)THRL)){ const float dl_=__builtin_fmaxf(rm,0.f); mhat+=dl_; _Pragma("unroll") for(int r=0;r<16;++r){PN0[r]-=dl_;PN1[r]-=dl_;} _Pragma("unroll") for(int r=0;r<16;++r)negm[r]=-mhat; asm volatile("":"+v"(negm)); \
        const float f_=EX2(-dl_); l_reg*=f_; { const int ln_=mk_lane(); if(ln_<32)((float*)(shm+L2_WS))[wid*64+ln_]=f_; } resc=true; } } \
  }while(0)
  int t=0;
  #pragma unroll 1
  for(;t+2<NT;t+=2){
    STEP2(pA0,pA1,pB0,pB1,t,true);
    STEP2(pB0,pB1,pA0,pA1,t+1,true);
  }
  STEP2(pA0,pA1,pB0,pB1,NT-2,true);
  STEP2(pB0,pB1,pA0,pA1,NT-1,false);
  if(!grpB){ if constexpr(!(EXPM&8)){ WAIT_BAR(0); } }
  #undef STEP2
  #undef TI
  #undef TOPBLK
  #undef G1
  #undef G2A
  #undef G2B
  #undef KL
  #undef VRDL
  #undef VRDH
  #undef VOFFL
  #undef PKW2
  #undef PAF2
  #undef VFR2
  #undef EXP4
  #undef ROWMAX_FIN
  #undef MX3
  #undef EX2
  #undef PIN2
  #undef DMAK
  #undef DMAV
  __builtin_amdgcn_s_setprio(0);
  {
    int tid2=(mk_lane()+((wv_)<<6)); asm volatile("":"+v"(tid2));
    const int lane_e=tid2&63,r32e=lane_e&31,hie=lane_e>>5;
    float*wsfe=(float*)(shm+L2_WS)+wid*64;
    {auto rr=__builtin_amdgcn_permlane32_swap(__float_as_uint(l_reg),__float_as_uint(l_reg),false,false);l_reg=__uint_as_float(rr[0])+__uint_as_float(rr[1]);}
    if(hie==0)wsfe[32+r32e]=l_reg;asm volatile("s_waitcnt lgkmcnt(0)":::"memory");
    float rli[16];
    #pragma unroll
    for(int r=0;r<16;++r)rli[r]=__builtin_amdgcn_rcpf(wsfe[32+crow(r,hie)]);
    bf16*Ow=O+((long)b*SEQ+qb*QB+wid*QBLK)*DM+hv*128;
    bf16*stg=(bf16*)(shm+L2_OST)+wid*2048;
    if(!combine){
      #pragma unroll
      for(int hf=0;hf<2;++hf){
        #pragma unroll
        for(int r=0;r<16;++r){const int orow=crow(r,hie);
          #pragma unroll
          for(int d0=0;d0<2;++d0)stg[orow*64+d0*32+r32e]=__float2bfloat16(o[2*hf+d0][r]*rli[r]);}
        asm volatile("s_waitcnt lgkmcnt(0)":::"memory");
        #pragma unroll
        for(int i=0;i<4;++i){const int row=i*8+(lane_e>>3),ch=lane_e&7; const u32x4 v=*(const u32x4*)(stg+row*64+ch*8); ATTN_STORE16(Ow+(long)row*DM+hf*64+ch*8,v);}
        asm volatile("s_waitcnt lgkmcnt(0)":::"memory"); }
    } else {
      const float lam2=*lamp; const float osc2=oscale;
      u32x4 o0c[2][4];
      #pragma unroll
      for(int hf=0;hf<2;++hf)
        #pragma unroll
        for(int i=0;i<4;++i) o0c[hf][i]=*(const u32x4*)(Ow+(long)(i*8+(lane_e>>3))*DM+hf*64+(lane_e&7)*8);
      float dd[2][4][8]; float ssq[4]={0.f,0.f,0.f,0.f};
      #pragma unroll
      for(int hf=0;hf<2;++hf){
        #pragma unroll
        for(int r=0;r<16;++r){const int orow=crow(r,hie);
          #pragma unroll
          for(int d0=0;d0<2;++d0)stg[orow*64+d0*32+r32e]=__float2bfloat16(o[2*hf+d0][r]*rli[r]);}
        asm volatile("s_waitcnt lgkmcnt(0)":::"memory");
        #pragma unroll
        for(int i=0;i<4;++i){const int row=i*8+(lane_e>>3),ch=lane_e&7; const u32x4 v=*(const u32x4*)(stg+row*64+ch*8);
          #pragma unroll
          for(int e=0;e<4;++e){ const float a0=__uint_as_float(o0c[hf][i][e]<<16),a1=__uint_as_float(o0c[hf][i][e]&0xffff0000u),b0=__uint_as_float(v[e]<<16),b1=__uint_as_float(v[e]&0xffff0000u);
            const float x0=a0-lam2*b0,x1=a1-lam2*b1; dd[hf][i][2*e]=x0; dd[hf][i][2*e+1]=x1; ssq[i]+=x0*x0+x1*x1; } }
        asm volatile("s_waitcnt lgkmcnt(0)":::"memory"); }
      #pragma unroll
      for(int i=0;i<4;++i){ float q=ssq[i];
        q+=__uint_as_float(__builtin_amdgcn_update_dpp(0u,__float_as_uint(q),0xB1,0xF,0xF,true)); q+=__uint_as_float(__builtin_amdgcn_update_dpp(0u,__float_as_uint(q),0x4E,0xF,0xF,true)); q+=__uint_as_float(__builtin_amdgcn_update_dpp(0u,__float_as_uint(q),0x141,0xF,0xF,true));
        ssq[i]=osc2*__builtin_amdgcn_rsqf(q*(1.0f/128.0f)+1e-6f); }
      #pragma unroll
      for(int hf=0;hf<2;++hf){ const float*gp=sg+hf*64+(lane_e&7)*8; const f32x4m g0=*reinterpret_cast<const f32x4m*>(gp), g1=*reinterpret_cast<const f32x4m*>(gp+4);
        #pragma unroll
        for(int i=0;i<4;++i){ const int row=i*8+(lane_e>>3),ch=lane_e&7; const float rr_=ssq[i]; u32x4 w;
          w[0]=cvtpk_s(dd[hf][i][0]*rr_*g0[0],dd[hf][i][1]*rr_*g0[1]); w[1]=cvtpk_s(dd[hf][i][2]*rr_*g0[2],dd[hf][i][3]*rr_*g0[3]);
          w[2]=cvtpk_s(dd[hf][i][4]*rr_*g1[0],dd[hf][i][5]*rr_*g1[1]); w[3]=cvtpk_s(dd[hf][i][6]*rr_*g1[2],dd[hf][i][7]*rr_*g1[3]);
          ATTN_STORE16(Ow+(long)row*DM+hf*64+ch*8,w); } }
    } }
}

#undef SBAR
#undef WAIT_BAR
}


namespace cg = cooperative_groups;
#define LAS __attribute__((address_space(3)))
typedef unsigned short u16;
typedef unsigned v4u __attribute__((ext_vector_type(4)));
typedef unsigned v2u __attribute__((ext_vector_type(2)));
typedef float f32x4 __attribute__((ext_vector_type(4)));
typedef float f32x16 __attribute__((ext_vector_type(16)));
typedef short bf16x8 __attribute__((ext_vector_type(8)));

#define RLX_AGENT __ATOMIC_RELAXED, __HIP_MEMORY_SCOPE_AGENT
#define XB_TMO      128
#define XB_XCNT(j)  (256  + 64 * (j))
#define XB_XSUB(j)  (1280 + 64 * (j))
#define XB_XGEN(j)  (2304 + 64 * (j))
#define XB_TOP      3328
#define XB_TOPGEN   3392
#define XCD_BAR_WORDS 3456
#define XB_SPIN_CAP (1u << 18)

__device__ __forceinline__ unsigned xb_ld(unsigned* p)              { return __hip_atomic_load(p, __ATOMIC_RELAXED, __HIP_MEMORY_SCOPE_AGENT); }
__device__ __forceinline__ unsigned xb_add(unsigned* p, unsigned v) { return __hip_atomic_fetch_add(p, v, __ATOMIC_RELAXED, __HIP_MEMORY_SCOPE_AGENT); }
__device__ __forceinline__ unsigned xb_xcc_id() { return (unsigned)__builtin_amdgcn_s_getreg((3 << 11) | 20) & 0xFu; }
#define XB_SPIN(cond, bar) do { unsigned _sp = 0; while (cond) { __builtin_amdgcn_s_sleep(1); \
    if ((++_sp & 255u) == 0u) { if (xb_ld(&(bar)[XB_TMO])) break; if (_sp > XB_SPIN_CAP) { atomicAdd(&(bar)[XB_TMO], 1u); break; } } } } while (0)

struct XcdBarrier {
    unsigned* bar; unsigned x;
    volatile LAS unsigned* st;
};

__device__ __forceinline__ XcdBarrier xcd_barrier_post(unsigned* bar, volatile LAS unsigned* st, const int wv_) {
    XcdBarrier b; b.bar = bar; b.x = xb_xcc_id(); b.st = st;
    if ((mk_lane()+((wv_)<<6)) == 0) (void)xb_add(&bar[XB_XCNT(b.x)], 1u);
    return b;
}
__device__ __forceinline__ void xcd_barrier_complete(unsigned* bar, unsigned x, unsigned& nloc, unsigned& nx) {
    const unsigned G = gridDim.x * gridDim.y * gridDim.z;
    unsigned sum, cnt, mine, sp = 0u;
    for (;;) {
        sum = 0u; cnt = 0u; mine = 0u;
#pragma unroll
        for (unsigned j = 0; j < 16; ++j) { const unsigned c = xb_ld(&bar[XB_XCNT(j)]); sum += c; cnt += (c > 0u) ? 1u : 0u; mine = (j == x) ? c : mine; }
        if (sum == G) break;
        __builtin_amdgcn_s_sleep(1);
        if ((++sp & 255u) == 0u) { if (xb_ld(&bar[XB_TMO])) break; if (sp > XB_SPIN_CAP) { atomicAdd(&bar[XB_TMO], 1u); break; } }
    }
    nloc = mine > 0u ? mine : 1u; nx = cnt > 0u ? cnt : 1u;
}

__device__ __forceinline__ void xcd_barrier(const XcdBarrier& b, const int wv_) {
    asm volatile("s_waitcnt vmcnt(0)" ::: "memory");
    __syncthreads();
    if ((mk_lane()+((wv_)<<6)) == 0) {
        unsigned* bar = b.bar;
        __builtin_amdgcn_s_waitcnt(0);
        unsigned nloc = b.st[0], nx = b.st[1];
        if (nloc == 0u) { xcd_barrier_complete(bar, b.x, nloc, nx); b.st[0] = nloc; b.st[1] = nx; }
        const unsigned old = xb_add(&bar[XB_XSUB(b.x)], 1u);
        const unsigned gen = old / nloc;
        if (old + 1u == (gen + 1u) * nloc) {
            __builtin_amdgcn_fence(__ATOMIC_RELEASE, "agent");
            asm volatile("s_waitcnt vmcnt(0)" ::: "memory");
            const unsigned og = xb_add(&bar[XB_TOP], 1u);
            const unsigned tg = og / nx;
            if (og + 1u == (tg + 1u) * nx) xb_add(&bar[XB_TOPGEN], 1u);
            else XB_SPIN(xb_ld(&bar[XB_TOPGEN]) == tg, bar);
            __builtin_amdgcn_fence(__ATOMIC_ACQUIRE, "agent");
            xb_add(&bar[XB_XGEN(b.x)], 1u);
            asm volatile("s_waitcnt vmcnt(0)" ::: "memory");
        } else {
            XB_SPIN(xb_ld(&bar[XB_XGEN(b.x)]) == gen, bar);
            __builtin_amdgcn_fence(__ATOMIC_ACQUIRE, "agent");
            asm volatile("s_waitcnt vmcnt(0)" ::: "memory");
        }
    }
    __syncthreads();
}

constexpr int NWAVES = 8;
constexpr int BATCH = 4, SEQ = 8192, DMODEL = 1024, FF = 2816, M = BATCH * SEQ;
constexpr int LDS_BYTES = 147456;
constexpr size_t MiB = 1u << 20;
constexpr size_t WS_ROPE = 0;
constexpr size_t WS_KMEAN = 1 * MiB;
constexpr size_t WS_SS = 2 * MiB;
constexpr size_t WS_LAM = 6 * MiB;
constexpr size_t WS_BAR = 5 * MiB;
constexpr size_t WS_RDY = 5 * MiB + 64 * 1024;
constexpr unsigned BAR_MAGIC = 0x5eed1234u;
constexpr size_t WS_WSB = 4 * MiB;
constexpr size_t WS_W = 8 * MiB;
constexpr size_t WS_XB = 96 * MiB;
constexpr size_t WS_H = 160 * MiB;
constexpr size_t WS_EQ = 160 * MiB;
constexpr size_t WS_EY = 336 * MiB;
constexpr size_t WS_OQ = 160 * MiB;
constexpr size_t WS_O0 = 352 * MiB, WS_O1 = 416 * MiB;
constexpr size_t WS_END = 480 * MiB;
constexpr size_t W_GU = 0, W_GU_SZ = (size_t)2 * FF * DMODEL, W_DN = 4 * W_GU_SZ, W_DN_SZ = (size_t)FF * DMODEL;
constexpr size_t W_EIN = W_DN + 4 * W_DN_SZ, W_EOUT = W_EIN + (size_t)2560 * 1024, W_OIN = W_EOUT + (size_t)1024 * 1024, W_OOUT = W_OIN + (size_t)3072 * 1024, W_ENDE = W_OOUT + (size_t)1024 * 1024;
static_assert(WS_W + W_ENDE * 2 <= WS_XB, "weights fit");
constexpr float C2Q = 0.125f * 1.4426950408889634f;

__device__ __forceinline__ float wave_sum(float v) {
#pragma unroll
    for (int o = 1; o < 64; o <<= 1) v += __shfl_xor(v, o);
    return v;
}
__device__ __forceinline__ unsigned f2bf(float f) { unsigned u = __builtin_bit_cast(unsigned, f); return (u + 0x7fffu + ((u >> 16) & 1u)) >> 16; }
__device__ __forceinline__ unsigned pk2(float lo, float hi) { return f2bf(lo) | (f2bf(hi) << 16); }
__device__ __forceinline__ float bf2f(unsigned h) { return __builtin_bit_cast(float, h << 16); }
__device__ __forceinline__ int dimof(int p) { return p < 16 ? ((p & 1) ? (p >> 1) + 8 : (p >> 1)) : p; }

__device__ __forceinline__ int physof(int d) { return d < 8 ? 2 * d : (d < 16 ? 2 * (d - 8) + 1 : d); }
__device__ __forceinline__ void tr_item(const float* W, int K, int Nsrc, int scol0, bool perm, const float* gain, u16* WT, int n0dst, int k0, LAS float* scr, int lane) {
    const int rr = lane >> 3, c4 = (lane & 7) * 4;
    f32x4 w[8];
#pragma unroll
    for (int i = 0; i < 8; ++i) w[i] = *(const f32x4*)(W + (size_t)(k0 + 8 * i + rr) * Nsrc + scol0 + c4);
    int dp[4];
#pragma unroll
    for (int j = 0; j < 4; ++j) dp[j] = perm ? physof(c4 + j) : (c4 + j);
#pragma unroll
    for (int i = 0; i < 8; ++i) { const int kk = 8 * i + rr; const float g = gain ? gain[k0 + kk] : 1.0f;
#pragma unroll
        for (int j = 0; j < 4; ++j) scr[kk * 33 + dp[j]] = w[i][j] * g; }
    asm volatile("s_waitcnt lgkmcnt(0)" ::: "memory");
    const int c = lane & 7;
#pragma unroll
    for (int j = 0; j < 4; ++j) { const int n = (lane >> 3) + 8 * j; const LAS float* s = scr + (8 * c) * 33 + n;
        v4u o; o.x = pk2(s[0 * 33], s[1 * 33]); o.y = pk2(s[2 * 33], s[3 * 33]); o.z = pk2(s[4 * 33], s[5 * 33]); o.w = pk2(s[6 * 33], s[7 * 33]);
        *(v4u*)(WT + (size_t)(n0dst + n) * K + k0 + 8 * c) = o; }
    asm volatile("s_waitcnt lgkmcnt(0)" ::: "memory");
}

#ifndef PHASES
#define PHASES 0xff
#endif
#define PHON(k) (((PHASES) >> (k)) & 1)
#ifndef NOATT
#define NOATT 0
#endif
#ifndef NOGMLP
#define NOGMLP 0
#endif
struct Args { const float* in[24]; float* out; unsigned char* ws; };

__device__ __forceinline__ void gmlp_unit(int chunk, int g, int lane, LAS unsigned char* wl, const u16* U, const u16* Vg, const float* lng, const float* lnb, const u16* Wsb, const float* bs, u16* Y) {
    const int row0 = chunk * 128, r32 = lane & 31, hi = lane >> 5;
    LAS u16* vT = (LAS u16*)wl;
#pragma unroll 1
    for (int rr = 0; rr < 2; ++rr) { const int s = lane + 64 * rr; const v4u* vp = (const v4u*)(Vg + (size_t)(row0 + s) * 512 + g * 64);
        float v[64];
#pragma unroll
        for (int c = 0; c < 8; ++c) { const v4u w = vp[c];
#pragma unroll
            for (int e = 0; e < 4; ++e) { v[c * 8 + 2 * e] = bf2f(w[e] & 0xffffu); v[c * 8 + 2 * e + 1] = bf2f(w[e] >> 16); } }
        float sum = 0.f;
#pragma unroll
        for (int d = 0; d < 64; ++d) sum += v[d];
        const float mean = sum * (1.0f / 64.0f); float var = 0.f;
#pragma unroll
        for (int d = 0; d < 64; ++d) { v[d] -= mean; var += v[d] * v[d]; }
        const float rstd = 1.0f / sqrtf(var * (1.0f / 64.0f) + 1e-6f);
#pragma unroll
        for (int d = 0; d < 64; ++d) { const float y = v[d] * rstd * lng[g * 64 + d] + lnb[g * 64 + d]; vT[d * 136 + s] = (u16)f2bf(y); }
    }
    asm volatile("s_waitcnt lgkmcnt(0)" ::: "memory");
    const u16* Wg = Wsb + (size_t)g * 16384;
    f32x16 acc[4][2];
#pragma unroll
    for (int ti = 0; ti < 4; ++ti)
#pragma unroll
        for (int di = 0; di < 2; ++di) { acc[ti][di] = f32x16{};
#pragma unroll
            for (int ks = 0; ks < 2 * ti + 2; ++ks) { const bf16x8 a = *(const bf16x8*)(Wg + (size_t)(32 * ti + r32) * 128 + 16 * ks + 8 * hi);
                const bf16x8 b = *(const LAS bf16x8*)(vT + (32 * di + r32) * 136 + 16 * ks + 8 * hi);
                acc[ti][di] = __builtin_amdgcn_mfma_f32_32x32x16_bf16(a, b, acc[ti][di], 0, 0, 0); }
            __builtin_amdgcn_sched_barrier(0); }
    asm volatile("s_waitcnt lgkmcnt(0)" ::: "memory");
    LAS u16* mx = (LAS u16*)wl;
    LAS u16* mb = mx + (4 * hi) * 64 + r32;
#pragma unroll
    for (int ti = 0; ti < 4; ++ti)
#pragma unroll
        for (int di = 0; di < 2; ++di)
#pragma unroll
            for (int r = 0; r < 16; ++r) mb[(32 * ti + (r & 3) + 8 * (r >> 2)) * 64 + 32 * di] = (u16)f2bf(acc[ti][di][r]);
    v4u uc[16];
#pragma unroll
    for (int i = 0; i < 16; ++i) { const int id = i * 64 + lane; uc[i] = *(const v4u*)(U + (size_t)(row0 + (id >> 3)) * 512 + g * 64 + (id & 7) * 8); }
    asm volatile("s_waitcnt lgkmcnt(0)" ::: "memory");
#pragma unroll
    for (int i = 0; i < 16; ++i) { const int id = i * 64 + lane, t = id >> 3, ch = id & 7; const v4u mv = *(const LAS v4u*)(mx + t * 64 + ch * 8); const float bsv = bs[g * 128 + t]; v4u o;
#pragma unroll
        for (int e = 0; e < 4; ++e) o[e] = pk2(bf2f(uc[i][e] & 0xffffu) * (bf2f(mv[e] & 0xffffu) + bsv), bf2f(uc[i][e] >> 16) * (bf2f(mv[e] >> 16) + bsv));
        *(v4u*)(Y + (size_t)(row0 + t) * 1024 + 512 + g * 64 + ch * 8) = o; }
    asm volatile("s_waitcnt lgkmcnt(0)" ::: "memory");
}

template <int step> __device__ __forceinline__ void do_step(const Args& args, unsigned char* lds, const int wv_) {
    LAS unsigned char* ldsl = (LAS unsigned char*)lds;
    int tid_ = (mk_lane()+((wv_)<<6)); asm volatile("" : "+v"(tid_));
    const int tid = tid_, lane = tid & 63, wave = __builtin_amdgcn_readfirstlane(tid >> 6);
    const int G = gridDim.x, bx = blockIdx.x;
    const int vcu = (G % 8 == 0) ? (bx % 8) * (G / 8) + bx / 8 : bx;
    const int gw = vcu * NWAVES + wave, NGW = G * NWAVES;
    unsigned char* ws = args.ws;
    float* rope = (float*)(ws + WS_ROPE); float* kmean = (float*)(ws + WS_KMEAN); float* ss = (float*)(ws + WS_SS);
    u16* Wsb = (u16*)(ws + WS_WSB); u16* Wc = (u16*)(ws + WS_W); u16* XB = (u16*)(ws + WS_XB); u16* HB = (u16*)(ws + WS_H);
    float* out = args.out;
    (void)rope; (void)kmean; (void)ss; (void)Wsb; (void)Wc; (void)XB; (void)HB; (void)out; (void)gw; (void)NGW; (void)lane; (void)ldsl;
        if constexpr (PHON(0) && step == 0) {
            LAS float* scr = (LAS float*)(ldsl + wave * 16384);
            constexpr int I_GU = 16 * 176, I_DN = 44 * 32, I_EIN = 16 * 80, I_OUT = 16 * 32, I_OIN = 16 * 96;
            constexpr int NITEMS = 4 * I_GU + 4 * I_DN + I_EIN + I_OUT + I_OIN + I_OUT;
#ifndef P0REP_T
#define P0REP_T 1
#endif
#ifndef P0REP_X
#define P0REP_X 1
#endif
            for (int rep_t = 0; rep_t < P0REP_T; ++rep_t)
            for (int it = gw; it < NITEMS; it += NGW) {
                int r = it;
                if (r < 4 * I_GU) { const int f = r / I_GU; r -= f * I_GU; const int l = f >> 1, post = f & 1;
                    const int kb = r / 176, nb = r % 176, n0 = 32 * nb, c = n0 & 255, j0 = 128 * (n0 >> 8) + (c & 127);
                    const float* Wsrc = args.in[(post ? 7 : 2) + (c >= 128 ? 1 : 0)] + (size_t)l * 1024 * FF;
                    const float* gain = args.in[post ? 6 : 1] + l * 1024;
                    tr_item(Wsrc, 1024, FF, j0, false, gain, Wc + W_GU + (size_t)f * W_GU_SZ, n0, 64 * kb, scr, lane); continue; }
                r -= 4 * I_GU;
                if (r < 4 * I_DN) { const int f = r / I_DN; r -= f * I_DN; const int l = f >> 1, post = f & 1; const int kb = r / 32, nb = r % 32;
                    tr_item(args.in[post ? 9 : 4] + (size_t)l * FF * 1024, FF, 1024, 32 * nb, false, nullptr, Wc + W_DN + (size_t)f * W_DN_SZ, 32 * nb, 64 * kb, scr, lane); continue; }
                r -= 4 * I_DN;
                if (r < I_EIN) { const int kb = r / 80, nb = r % 80, n0 = 32 * nb;
                    tr_item(args.in[10], 1024, 2560, n0, (n0 < 1024) && ((n0 & 63) == 0), args.in[5], Wc + W_EIN, n0, 64 * kb, scr, lane); continue; }
                r -= I_EIN;
                if (r < I_OUT) { const int kb = r / 32, nb = r % 32; tr_item(args.in[11], 1024, 1024, 32 * nb, false, nullptr, Wc + W_EOUT, 32 * nb, 64 * kb, scr, lane); continue; }
                r -= I_OUT;
                if (r < I_OIN) { const int kb = r / 96, nb = r % 96, n0 = 32 * nb;
                    tr_item(args.in[16], 1024, 3072, n0, (n0 < 2048) && ((n0 & 63) == 0), args.in[5] + 1024, Wc + W_OIN, n0, 64 * kb, scr, lane); continue; }
                r -= I_OIN;
                { const int kb = r / 32, nb = r % 32; tr_item(args.in[17], 1024, 1024, 32 * nb, false, nullptr, Wc + W_OOUT, 32 * nb, 64 * kb, scr, lane); }
            }
            const int gt = vcu * 512 + tid, NGT = G * 512;
            for (int i = gt; i < 8192 * 8; i += NGT) { const int pos = i >> 3, k = i & 7;
                const float inv = 1.0f / powf(500000.0f, (float)(2 * k) / 16.0f); const float ang = (float)pos * inv;
                double t = (double)ang * 0.15915494309189535; t -= floor(t); const float fr = (float)t;
                rope[2 * i] = __builtin_amdgcn_cosf(fr); rope[2 * i + 1] = __builtin_amdgcn_sinf(fr); }
            for (int i = gt; i < BATCH * 32 * 512; i += NGT) kmean[i] = 0.f;
            if (gw == 0) { const float s1 = wave_sum(args.in[18][lane] * args.in[19][lane]), s2 = wave_sum(args.in[20][lane] * args.in[21][lane]);
                if (lane == 0) *(float*)(ws + WS_LAM) = expf(s1) - expf(s2) + 0.35550906759096927f; }
            for (int i = gt; i < 8 * 128 * 128; i += NGT) { const int t = (i >> 7) & 127, s = i & 127; Wsb[i] = (u16)f2bf(s <= t ? args.in[14][i] : 0.f); }
            const float* x = args.in[0];
            for (int rep_x = 0; rep_x < P0REP_X; ++rep_x)
            for (int m0 = 2 * gw; m0 < M; m0 += 2 * NGW) { f32x4 v[2][4];
#pragma unroll
                for (int q = 0; q < 2; ++q) { const f32x4* xr = (const f32x4*)(x + (size_t)(m0 + q) * 1024) + lane;
#pragma unroll
                    for (int j = 0; j < 4; ++j) v[q][j] = xr[64 * j]; }
#pragma unroll
                for (int q = 0; q < 2; ++q) { const int m = m0 + q; float s = 0.f;
#pragma unroll
                    for (int j = 0; j < 4; ++j) s += (v[q][j][0] * v[q][j][0] + v[q][j][1] * v[q][j][1]) + (v[q][j][2] * v[q][j][2] + v[q][j][3] * v[q][j][3]);
                    s = wave_sum(s);
                    v2u* o8 = (v2u*)(XB + (size_t)m * 1024) + lane;
#pragma unroll
                    for (int j = 0; j < 4; ++j) { v2u w; w.x = pk2(v[q][j][0], v[q][j][1]); w.y = pk2(v[q][j][2], v[q][j][3]); o8[64 * j] = w; }
                    if (lane < 16) ss[(size_t)m * 16 + lane] = (lane == 0) ? s : 0.f; } }
        } else if constexpr (PHON(1) && (step == 1 || step == 6 || step == 8 || step == 14)) {
            const int f = (step == 1) ? 0 : (step == 6) ? 1 : (step == 8) ? 2 : 3;
            pg8::Gemm g{XB, Wc + W_GU + (size_t)f * W_GU_SZ, M, 2 * FF, 1024}; pg8::StaticOrder S; S.init(M, 2 * FF, G, bx);
            pg8::EpiSwiglu E{HB, FF, ss};
            pg8::gemm_phase<pg8::EpiSwiglu, pg8::StaticOrder, true, true>(ldsl, g, S, E, wv_);
        } else if constexpr (PHON(2) && (step == 2 || step == 5 || step == 7 || step == 9 || step == 13 || step == 15)) {
            const u16* A; const u16* Bt; int K; float alpha = 0.5f;
            if (step == 2) { A = HB; Bt = Wc + W_DN; K = FF; }
            else if (step == 5) { A = (const u16*)(ws + WS_EY); Bt = Wc + W_EOUT; K = 1024; alpha = 1.0f; }
            else if (step == 7) { A = HB; Bt = Wc + W_DN + W_DN_SZ; K = FF; }
            else if (step == 9) { A = HB; Bt = Wc + W_DN + 2 * W_DN_SZ; K = FF; }
            else if (step == 13) { A = (const u16*)(ws + WS_O0); Bt = Wc + W_OOUT; K = 1024; alpha = 1.0f; }
            else { A = HB; Bt = Wc + W_DN + 3 * W_DN_SZ; K = FF; }
            pg8::Gemm g{A, Bt, M, 1024, K}; pg8::StaticOrder S; S.init(M, 1024, G, bx);
            pg8::EpiResid E{XB, ss, alpha};
            pg8::gemm_phase<pg8::EpiResid, pg8::StaticOrder, true, true>(ldsl, g, S, E, wv_);
        } else if constexpr (PHON(3) && (step == 3 || step == 10)) {
            const bool even = (step == 3); const int N = even ? 2560 : 3072;
            pg8::Gemm g{XB, Wc + (even ? W_EIN : W_OIN), M, N, 1024}; pg8::StaticOrder S; S.init(M, N, G, bx);
            pg8::EpiIn E{(u16*)(ws + (even ? WS_EQ : WS_OQ)), even ? (size_t)M * 512 : (size_t)M * 1024, even ? 2 : 4, ss, rope, even ? kmean : nullptr, C2Q};
            pg8::gemm_phase<pg8::EpiIn, pg8::StaticOrder, true, true>(ldsl, g, S, E, wv_);
        } else if constexpr (PHON(4) && step == 4) {
            const attn_body::bf16* Qe = (const attn_body::bf16*)(ws + WS_EQ); const attn_body::bf16* Ke = Qe + (size_t)M * 512; const attn_body::bf16* Ve = Ke + (size_t)M * 512;
            const u16* Ue = (const u16*)(ws + WS_EQ) + (size_t)3 * M * 512; const u16* Vge = Ue + (size_t)M * 512;
            u16* Y = (u16*)(ws + WS_EY);
            if (!NOATT) for (int it = 0; it < 4; ++it) { const int qd = vcu + (it >> 2) * G; if (qd >= 256) break; const int i = it & 3;
                const int bh = qd >> 3, s = qd & 7;
                const int qb = (i == 0) ? s : (i == 1) ? 15 - s : (i == 2) ? 16 + s : 31 - s;
                attn_body::attn_unit<8, 512, 1024, true>(bh >> 3, bh & 7, bh & 7, qb, Qe, Ke, Ve, (attn_body::bf16*)Y, (char*)lds, kmean, wv_); }
            __syncthreads();
#ifndef GMLPREP
#define GMLPREP 1
#endif
            for (int rep_ = 0; rep_ < GMLPREP; ++rep_) for (int c = vcu; c < 256; c += G)
                gmlp_unit(c, wave, lane, ldsl + wave * 17408, Ue, Vge, args.in[12], args.in[13], Wsb, args.in[15], Y);
        } else if constexpr (PHON(5) && step == 11) {
            const attn_body::bf16* Qo = (const attn_body::bf16*)(ws + WS_OQ); const attn_body::bf16* Ko = Qo + (size_t)M * 1024; const attn_body::bf16* Vo = Ko + (size_t)M * 1024;
            constexpr float linit = 0.35550906759096927f;
            for (int it = 0; ; ++it) { int b, h, c, qb, desc;
                if (G == 256) { if (it >= 8) break; const int x = vcu >> 5, j = vcu & 31, k = j & 15, bh = x * 4 + (it >> 2) * 2 + (j >> 4), u = it & 3; h = bh & 7; b = bh >> 3; c = u >> 1; qb = (u == 0 || u == 3) ? k : 31 - k; desc = u & 1; }
                else { const int tq = vcu + (it >> 1) * G; if (tq >= 1024) break; c = it & 1; qb = tq & 31; const int bh = tq >> 5; h = bh & 7; b = bh >> 3; desc = 0; }
                attn_body::attn_unit2<8, 1024>(b, 2 * h + c, h, qb, Qo, Ko, Vo, (attn_body::bf16*)(ws + WS_O0), (char*)lds, c, args.in[22], (const float*)(ws + WS_LAM), 1.0f - linit, desc, wv_); }
        } else if constexpr (PHON(6) && step == 12) {
        } else if constexpr (PHON(7) && step == 16) {
            const float* fg = args.in[23];
            for (int m0 = 2 * gw; m0 < M; m0 += 2 * NGW) { v2u w[2][4];
#pragma unroll
                for (int q = 0; q < 2; ++q) { const v2u* xr = (const v2u*)(XB + (size_t)(m0 + q) * 1024) + lane;
#pragma unroll
                    for (int j = 0; j < 4; ++j) w[q][j] = xr[64 * j]; }
#pragma unroll
                for (int q = 0; q < 2; ++q) { float s = 0.f; f32x4 v[4];
#pragma unroll
                    for (int j = 0; j < 4; ++j) { v[j] = (f32x4){bf2f(w[q][j].x & 0xffffu), bf2f(w[q][j].x >> 16), bf2f(w[q][j].y & 0xffffu), bf2f(w[q][j].y >> 16)};
                        s += (v[j][0] * v[j][0] + v[j][1] * v[j][1]) + (v[j][2] * v[j][2] + v[j][3] * v[j][3]); }
                    const float r = 1.0f / sqrtf(wave_sum(s) * (1.0f / 1024.0f) + 1e-6f);
                    f32x4* orow = (f32x4*)(out + (size_t)(m0 + q) * 1024) + lane;
#pragma unroll
                    for (int j = 0; j < 4; ++j) { const f32x4 gg = *((const f32x4*)fg + lane + 64 * j); orow[64 * j] = v[j] * r * gg; } } }
        }
}

__global__ void __launch_bounds__(NWAVES * 64, 2) mk_fwd(Args args) {
    extern __shared__ __attribute__((aligned(16))) unsigned char lds[];
    cg::grid_group grid = cg::this_grid();
    volatile LAS unsigned* MISC = (volatile LAS unsigned*)((LAS unsigned char*)lds + LDS_BYTES - 128);
    const int wv_ = __builtin_amdgcn_readfirstlane(threadIdx.x >> 6);
    if (threadIdx.x < 32) MISC[threadIdx.x] = 0u;
    __syncthreads();
#ifndef DUPMASK
#define DUPMASK 0
#endif
#ifndef EXTRASYNC
#define EXTRASYNC 0
#endif
    { unsigned* rdy = (unsigned*)(args.ws + WS_RDY);
      if (blockIdx.x == 0) { for (int i = threadIdx.x; i < 4096; i += NWAVES * 64) ((unsigned*)(args.ws + WS_BAR))[i] = 0u;
          __threadfence(); __syncthreads();
          if (threadIdx.x == 0) __hip_atomic_store(rdy, BAR_MAGIC, __ATOMIC_RELEASE, __HIP_MEMORY_SCOPE_AGENT); }
      if (threadIdx.x == 0) { while (__hip_atomic_load(rdy, __ATOMIC_RELAXED, __HIP_MEMORY_SCOPE_AGENT) != BAR_MAGIC) __builtin_amdgcn_s_sleep(2);
          __builtin_amdgcn_fence(__ATOMIC_ACQUIRE, "agent"); }
      __syncthreads(); }
    const XcdBarrier bar = xcd_barrier_post((unsigned*)(args.ws + WS_BAR), MISC + 8, wv_);
    if (args.ws == nullptr) grid.sync();
    do_step<0>(args, lds, wv_); xcd_barrier(bar, wv_);
#define STEP_(k) do_step<k>(args, lds, wv_); xcd_barrier(bar, wv_); if constexpr ((DUPMASK >> k) & 1) { do_step<k>(args, lds, wv_); xcd_barrier(bar, wv_); }
    STEP_(1) STEP_(2) STEP_(3) STEP_(4) STEP_(5) STEP_(6) STEP_(7) STEP_(8) STEP_(9) STEP_(10) STEP_(11) STEP_(13) STEP_(14) STEP_(15)
    for (int i = 0; i < EXTRASYNC; ++i) xcd_barrier(bar, wv_);
    if (blockIdx.x == 0 && wv_ == 0 && mk_lane() == 0) __hip_atomic_store((unsigned*)(args.ws + WS_RDY), 0u, __ATOMIC_RELAXED, __HIP_MEMORY_SCOPE_AGENT);
    do_step<16>(args, lds, wv_);
#undef STEP_
}

extern "C" void kernel_launch(void* const* d_in, const int* in_sizes, int n_in, void* d_out, int out_size, void* d_ws, size_t ws_size, hipStream_t stream) {
    static int grid = 0;
    if (grid == 0) {
        if (n_in != 24 || out_size != M * DMODEL || ws_size < WS_END) { fprintf(stderr, "kernel_launch: unexpected shapes (n_in %d out %d ws %zu)\n", n_in, out_size, ws_size); grid = -1; return; }
        int dev = 0, cus = 0, per_cu = 0;
        hipGetDevice(&dev); hipDeviceGetAttribute(&cus, hipDeviceAttributeMultiprocessorCount, dev);
        if (hipFuncSetAttribute((const void*)mk_fwd, hipFuncAttributeMaxDynamicSharedMemorySize, LDS_BYTES) != hipSuccess) { fprintf(stderr, "kernel_launch: hipFuncSetAttribute failed\n"); grid = -1; return; }
        if (hipOccupancyMaxActiveBlocksPerMultiprocessor(&per_cu, (const void*)mk_fwd, NWAVES * 64, LDS_BYTES) != hipSuccess || per_cu < 1) { fprintf(stderr, "kernel_launch: occupancy query says %d\n", per_cu); per_cu = 1; }
        (void)hipGetLastError();
        grid = cus * per_cu;
    }
    if (grid < 0) return;
    Args a{};
    for (int i = 0; i < 24; ++i) a.in[i] = (const float*)d_in[i];
    a.out = (float*)d_out; a.ws = (unsigned char*)d_ws;
    void* kargs[] = {&a};
    hipError_t e = hipLaunchCooperativeKernel((const void*)mk_fwd, dim3(grid), dim3(NWAVES * 64), kargs, LDS_BYTES, stream);
    if (e != hipSuccess) fprintf(stderr, "cooperative launch failed: %s (grid %d)\n", hipGetErrorString(e), grid);
}
```
